# Optimizing an MI355X kernel written in HIP

```python
import math
import jax, jax.numpy as jnp
from jax import lax
import numpy as np

D_MODEL = 1024
BATCH = 4
SEQ = 8192
DEPTH = 4

EPS = 1e-6
MLA_HEADS = 4
MLA_NOPE = 128
MLA_ROPE = 64
MLA_V = 128
MLA_Q_RANK = 384
MLA_KV_RANK = 256
MLA_ROPE_BASE = 10000.0
Q_BLOCK = 128
GLA_HEADS = 4
GLA_DK = 32
GLA_DV = 64
GLA_GATE_RANK = 16
GLA_GATE_NORM = 16.0
GLA_CHUNK = 64
RET_HEADS = 4
RET_DK = 32
RET_DV = 64
RET_CHUNK = 64
RET_ROPE_BASE = 10000.0
D_MIX = MLA_HEADS * MLA_V + GLA_HEADS * GLA_DV + RET_HEADS * RET_DV
IN_SIZES = (MLA_Q_RANK, MLA_KV_RANK, MLA_ROPE,
            GLA_HEADS * GLA_DK, GLA_HEADS * GLA_DK, GLA_HEADS * GLA_DV, GLA_GATE_RANK, GLA_HEADS * GLA_DV,
            RET_HEADS * RET_DK, RET_HEADS * RET_DK, RET_HEADS * RET_DV, RET_HEADS * RET_DV)
D_IN = sum(IN_SIZES)
D_FF = 2816
CONV_W = 3

kernel_name = "hybrid_mla_gla_retnet_convffn"


def rmsnorm(x, gain):
    xf = x.astype(jnp.float32)
    y = xf * lax.rsqrt(jnp.mean(xf * xf, axis=-1, keepdims=True) + EPS)
    return (y * gain.astype(jnp.float32)).astype(x.dtype)


def head_rmsnorm(x, gain):
    H, d = x.shape[-2], x.shape[-1]
    return rmsnorm(x, gain.reshape(H, d))


def rope_tables(S, dim, base):
    inv = base ** (-(jnp.arange(0, dim, 2, dtype=jnp.float32) / dim))
    ang = jnp.arange(S, dtype=jnp.float32)[:, None] * inv[None, :]
    return jnp.cos(ang), jnp.sin(ang)


def apply_rope(x, cos, sin):
    half = x.shape[-1] // 2
    c = cos[None, :, None, :].astype(x.dtype)
    s = sin[None, :, None, :].astype(x.dtype)
    x1, x2 = x[..., :half], x[..., half:]
    return jnp.concatenate([x1 * c - x2 * s, x2 * c + x1 * s], axis=-1)


def mla_attention(q_nope, q_rope, k_nope, k_rope, v):
    B, S, H, dn = q_nope.shape
    dr = q_rope.shape[-1]
    nb = S // Q_BLOCK
    scale = (MLA_NOPE + MLA_ROPE) ** -0.5
    qn = q_nope.reshape(B, nb, Q_BLOCK, H, dn).transpose(1, 0, 2, 3, 4)
    qr = q_rope.reshape(B, nb, Q_BLOCK, H, dr).transpose(1, 0, 2, 3, 4)
    key_pos = jnp.arange(S)

    def one_block(args):
        qn_b, qr_b, start = args
        s = (jnp.einsum('bqhd,bkhd->bhqk', qn_b, k_nope)
             + jnp.einsum('bqhd,bkd->bhqk', qr_b, k_rope)).astype(jnp.float32) * scale
        q_pos = start + jnp.arange(Q_BLOCK)
        mask = key_pos[None, :] <= q_pos[:, None]
        s = jnp.where(mask[None, None], s, jnp.finfo(jnp.float32).min)
        p = jax.nn.softmax(s, axis=-1).astype(v.dtype)
        return jnp.einsum('bhqk,bkhd->bqhd', p, v)

    out = lax.map(one_block, (qn, qr, jnp.arange(nb) * Q_BLOCK))
    return out.transpose(1, 0, 2, 3, 4).reshape(B, S, H, v.shape[-1])


def mla_branch(c_q, c_kv, k_rope, q_norm, w_uq, kv_norm, w_ukv, cos, sin):
    B, S, _ = c_q.shape
    q = (rmsnorm(c_q, q_norm) @ w_uq).reshape(B, S, MLA_HEADS, MLA_NOPE + MLA_ROPE)
    q_nope, q_rope = q[..., :MLA_NOPE], apply_rope(q[..., MLA_NOPE:], cos, sin)
    kv = (rmsnorm(c_kv, kv_norm) @ w_ukv).reshape(B, S, MLA_HEADS, MLA_NOPE + MLA_V)
    k_nope, v = kv[..., :MLA_NOPE], kv[..., MLA_NOPE:]
    k_r = apply_rope(k_rope[:, :, None, :], cos, sin)[:, :, 0, :]
    return mla_attention(q_nope, q_rope, k_nope, k_r, v)


def gla_chunked(q, k, v, log_a):
    B, S, H, dk = q.shape
    dv = v.shape[-1]
    C = GLA_CHUNK
    n = S // C
    to_chunks = lambda t: t.astype(jnp.float32).reshape(B, n, C, H, t.shape[-1]).transpose(1, 0, 3, 2, 4)
    qc, kc, vc, gc = to_chunks(q), to_chunks(k), to_chunks(v), to_chunks(log_a)
    tril = jnp.tril(jnp.ones((C, C), dtype=bool))

    def step(state, inp):
        qb, kb, vb, gb = inp
        b = jnp.cumsum(gb, axis=-2)
        inter = jnp.einsum('bhik,bhkv->bhiv', qb * jnp.exp(b), state)
        diff = b[..., :, None, :] - b[..., None, :, :]
        dec = jnp.where(tril[:, :, None], jnp.exp(jnp.where(tril[:, :, None], diff, 0.0)), 0.0)
        A = jnp.einsum('bhik,bhjk,bhijk->bhij', qb, kb, dec)
        intra = jnp.einsum('bhij,bhjv->bhiv', A, vb)
        b_end = b[..., -1:, :]
        new_state = state * jnp.exp(b_end)[..., 0, :, None] + jnp.einsum(
            'bhjk,bhjv->bhkv', kb * jnp.exp(b_end - b), vb)
        return new_state, inter + intra

    state0 = jnp.zeros((B, H, dk, dv), jnp.float32)
    _, out = lax.scan(step, state0, (qc, kc, vc, gc))
    return out.transpose(1, 0, 3, 2, 4).reshape(B, S, H, dv).astype(v.dtype)


def gla_branch(q, k, v, gate_lr, g, w_gate, b_gate, out_norm):
    B, S, _ = q.shape
    qh = q.reshape(B, S, GLA_HEADS, GLA_DK) * (GLA_DK ** -0.5)
    kh = k.reshape(B, S, GLA_HEADS, GLA_DK)
    vh = v.reshape(B, S, GLA_HEADS, GLA_DV)
    gk = (gate_lr @ w_gate + b_gate).astype(jnp.float32)
    log_a = (jax.nn.log_sigmoid(gk) / GLA_GATE_NORM).reshape(B, S, GLA_HEADS, GLA_DK)
    o = gla_chunked(qh, kh, vh, log_a)
    o = head_rmsnorm(o, out_norm).reshape(B, S, GLA_HEADS * GLA_DV)
    return o * jax.nn.silu(g)


def retention_chunked(q, k, v):
    B, S, H, dk = q.shape
    dv = v.shape[-1]
    C = RET_CHUNK
    n = S // C
    to_chunks = lambda t: t.astype(jnp.float32).reshape(B, n, C, H, t.shape[-1]).transpose(0, 3, 1, 2, 4)
    qc, kc, vc = to_chunks(q), to_chunks(k), to_chunks(v)
    log_g = jnp.log(1.0 - 2.0 ** (-5.0 - jnp.arange(H, dtype=jnp.float32)))
    idx = jnp.arange(C, dtype=jnp.float32)
    diff = idx[:, None] - idx[None, :]
    D = jnp.where(diff >= 0, jnp.exp(log_g[:, None, None] * jnp.maximum(diff, 0.0)), 0.0)
    scores = jnp.einsum('bhnid,bhnjd->bhnij', qc, kc) * D[None, :, None]
    intra = jnp.einsum('bhnij,bhnjv->bhniv', scores, vc)
    k_dec = kc * jnp.exp(log_g[:, None] * (C - 1 - idx)[None, :])[None, :, None, :, None]
    U = jnp.einsum('bhnjd,bhnjv->nbhdv', k_dec, vc)
    chunk_decay = jnp.exp(log_g * C)[None, :, None, None]

    def step(R, u):
        return R * chunk_decay + u, R

    _, R_prev = lax.scan(step, jnp.zeros((B, H, dk, dv), jnp.float32), U)
    q_dec = qc * jnp.exp(log_g[:, None] * (idx + 1.0)[None, :])[None, :, None, :, None]
    inter = jnp.einsum('bhnid,nbhdv->bhniv', q_dec, R_prev)
    out = (intra + inter).transpose(0, 2, 3, 1, 4).reshape(B, S, H, dv)
    return out.astype(v.dtype)


def retention_branch(q, k, v, g, out_norm, cos, sin):
    B, S, _ = q.shape
    qh = apply_rope(q.reshape(B, S, RET_HEADS, RET_DK), cos, sin)
    kh = apply_rope(k.reshape(B, S, RET_HEADS, RET_DK), cos, sin) * (RET_DK ** -0.5)
    vh = v.reshape(B, S, RET_HEADS, RET_DV)
    o = retention_chunked(qh, kh, vh)
    o = head_rmsnorm(o, out_norm).reshape(B, S, RET_HEADS * RET_DV)
    return o * jax.nn.silu(g)


def causal_dwconv(a, w, b):
    S = a.shape[1]
    p = jnp.pad(a, ((0, 0), (CONV_W - 1, 0), (0, 0)))
    out = b
    for kk in range(CONV_W):
        out = out + p[:, kk:kk + S] * w[kk]
    return out


def setup_inputs(seed: int = 0) -> dict:
    key = jax.random.key(seed)
    ks = jax.random.split(key, 19)
    f32 = jnp.float32
    nrm = lambda k, shape, scale: jax.random.normal(k, shape, f32) * scale
    gain = lambda k, shape: 1.0 + 0.02 * jax.random.normal(k, shape, f32)
    return {
        "x": nrm(ks[0], (BATCH, SEQ, D_MODEL), 1.0),
        "attn_norm": gain(ks[1], (DEPTH, D_MODEL)),
        "w_in": nrm(ks[2], (DEPTH, D_MODEL, D_IN), D_MODEL ** -0.5),
        "mla_q_norm": gain(ks[3], (DEPTH, MLA_Q_RANK)),
        "mla_w_uq": nrm(ks[4], (DEPTH, MLA_Q_RANK, MLA_HEADS * (MLA_NOPE + MLA_ROPE)), MLA_Q_RANK ** -0.5),
        "mla_kv_norm": gain(ks[5], (DEPTH, MLA_KV_RANK)),
        "mla_w_ukv": nrm(ks[6], (DEPTH, MLA_KV_RANK, MLA_HEADS * (MLA_NOPE + MLA_V)), MLA_KV_RANK ** -0.5),
        "mla_out_norm": gain(ks[7], (DEPTH, MLA_HEADS * MLA_V)),
        "gla_w_gate": nrm(ks[8], (DEPTH, GLA_GATE_RANK, GLA_HEADS * GLA_DK), GLA_GATE_RANK ** -0.5),
        "gla_b_gate": nrm(ks[9], (DEPTH, GLA_HEADS * GLA_DK), 0.02),
        "gla_out_norm": gain(ks[10], (DEPTH, GLA_HEADS * GLA_DV)),
        "ret_out_norm": gain(ks[11], (DEPTH, RET_HEADS * RET_DV)),
        "w_out": nrm(ks[12], (DEPTH, D_MIX, D_MODEL), D_MIX ** -0.5),
        "ffn_norm": gain(ks[13], (DEPTH, D_MODEL)),
        "ffn_w_up": nrm(ks[14], (DEPTH, D_MODEL, 2 * D_FF), D_MODEL ** -0.5),
        "ffn_conv_w": nrm(ks[15], (DEPTH, CONV_W, D_FF), CONV_W ** -0.5),
        "ffn_conv_b": nrm(ks[16], (DEPTH, D_FF), 0.02),
        "ffn_w_down": nrm(ks[17], (DEPTH, D_FF, D_MODEL), D_FF ** -0.5),
        "final_norm": gain(ks[18], (D_MODEL,)),
    }


def reference(x, attn_norm, w_in, mla_q_norm, mla_w_uq, mla_kv_norm, mla_w_ukv, mla_out_norm,
              gla_w_gate, gla_b_gate, gla_out_norm, ret_out_norm, w_out, ffn_norm, ffn_w_up,
              ffn_conv_w, ffn_conv_b, ffn_w_down, final_norm):
    B, S, _ = x.shape
    mla_cos, mla_sin = rope_tables(S, MLA_ROPE, MLA_ROPE_BASE)
    ret_cos, ret_sin = rope_tables(S, RET_DK, RET_ROPE_BASE)
    split_points = []
    acc = 0
    for sz in IN_SIZES[:-1]:
        acc += sz
        split_points.append(acc)

    for l in range(DEPTH):
        h = rmsnorm(x, attn_norm[l])
        z = h @ w_in[l]
        (c_q, c_kv, k_rope, g_q, g_k, g_v, g_lr, g_g, r_q, r_k, r_v, r_g) = jnp.split(z, split_points, axis=-1)
        y_a = mla_branch(c_q, c_kv, k_rope, mla_q_norm[l], mla_w_uq[l], mla_kv_norm[l], mla_w_ukv[l],
                         mla_cos, mla_sin)
        y_a = head_rmsnorm(y_a, mla_out_norm[l]).reshape(B, S, MLA_HEADS * MLA_V)
        y_b = gla_branch(g_q, g_k, g_v, g_lr, g_g, gla_w_gate[l], gla_b_gate[l], gla_out_norm[l])
        y_c = retention_branch(r_q, r_k, r_v, r_g, ret_out_norm[l], ret_cos, ret_sin)
        x = x + jnp.concatenate([y_a, y_b, y_c], axis=-1) @ w_out[l]
        h = rmsnorm(x, ffn_norm[l])
        u = h @ ffn_w_up[l]
        a, bv = u[..., :D_FF], u[..., D_FF:]
        a = causal_dwconv(a, ffn_conv_w[l], ffn_conv_b[l])
        x = x + (jax.nn.silu(a) * bv) @ ffn_w_down[l]

    return rmsnorm(x, final_norm)
```

```cpp
#include <hip/hip_runtime.h>
#include <cstdio>
#include <cstdint>

#ifndef ONE_LAUNCH
#define ONE_LAUNCH 1
#endif
#ifndef PMASK
#define PMASK 0xffff
#endif
#define EN(x) ((PMASK >> (x)) & 1)
#ifndef REP_MASK
#define REP_MASK 0
#endif
#ifndef LPROBE
#define LPROBE 0
#endif
#ifndef REP_NOEPI
#define REP_NOEPI 0
#endif
#define REP(x) for (int rep_ = 0; rep_ < 1 + ((REP_MASK >> (x)) & 1); ++rep_) if (rep_ == 0 || (xcd_barrier(bar), true))

#define LAS __attribute__((address_space(3)))
typedef unsigned short bf16_t;
typedef short bf16x8 __attribute__((ext_vector_type(8)));
typedef short s16x4 __attribute__((ext_vector_type(4)));
typedef float f32x4 __attribute__((ext_vector_type(4)));
typedef float f32x2 __attribute__((ext_vector_type(2)));
typedef float f32x16 __attribute__((ext_vector_type(16)));
typedef unsigned u32x4 __attribute__((ext_vector_type(4)));
typedef unsigned u32x2 __attribute__((ext_vector_type(2)));
typedef LAS char* lptr;

constexpr int DM = 1024, NB = 4, SEQ = 8192, DEPTH = 4, MTOK = NB * SEQ;
constexpr int NZ = 2304;
constexpr int ZC_CQ = 0, ZC_CKV = 384, ZC_KR = 640, ZC_GQ = 704, ZC_GK = 832, ZC_GV = 960, ZC_GLR = 1216, ZC_GG = 1232, ZC_RQ = 1488, ZC_RK = 1616, ZC_RV = 1744, ZC_PAD = 2000, ZC_RG = 2048, ZC_END = 2256;
constexpr int DFF = 2816, NUP = 2 * DFF;
constexpr int NQ = 768, NKV = 1024;
constexpr float EPS = 1e-6f;

constexpr size_t al256(size_t x) { return (x + 255) & ~(size_t)255; }
constexpr size_t WS_BAR = 0;
constexpr size_t WS_SSQX = 16384;
constexpr size_t WS_SSQQ = WS_SSQX + (size_t)MTOK * 16;
constexpr size_t WS_SSQKV = WS_SSQQ + 8;
constexpr size_t WS_ROPEM = WS_SSQQ + (size_t)MTOK * 16;
constexpr size_t WS_ROPER = WS_ROPEM + (size_t)SEQ * 32 * 2 * 4;
constexpr int SUM_STRIDE = 2048 + 64;
constexpr size_t WS_SUMG = WS_ROPER + (size_t)SEQ * 16 * 2 * 4;
constexpr size_t WS_SUMR = WS_SUMG + (size_t)128 * SUM_STRIDE * 4;
constexpr size_t WS_HALO = WS_SUMR + (size_t)128 * SUM_STRIDE * 4;
constexpr size_t WS_HEADA = WS_HALO + (size_t)128 * 2 * DFF * 4;
constexpr size_t WS_HEADB = WS_HEADA + (size_t)128 * 2 * DFF * 4;
constexpr size_t WS_W = al256(WS_HEADB + (size_t)128 * 2 * DFF * 4);
constexpr size_t W_IN = 0, W_UQ = W_IN + (size_t)NZ * DM * 2, W_UKV = W_UQ + (size_t)NQ * 384 * 2, W_OUT = W_UKV + (size_t)NKV * 256 * 2,
                 W_UP = W_OUT + (size_t)DM * DM * 2, W_DN = W_UP + (size_t)NUP * DM * 2, W_LAYER = W_DN + (size_t)DM * DFF * 2;
constexpr size_t WS_XB = al256(WS_W + DEPTH * W_LAYER);
constexpr size_t WS_YCAT = WS_XB + (size_t)MTOK * DM * 2;
constexpr size_t WS_KR = WS_YCAT + (size_t)MTOK * DM * 2;
constexpr size_t WS_Z = WS_KR + (size_t)MTOK * 64 * 2;
constexpr size_t WS_Q = WS_Z + (size_t)MTOK * NZ * 2;
constexpr size_t WS_KV = WS_Q + (size_t)MTOK * NQ * 2;
constexpr size_t WS_G = WS_Z;
constexpr size_t WS_END = WS_KV + (size_t)MTOK * NKV * 2;
static_assert(WS_G + (size_t)MTOK * DFF * 2 <= WS_END, "G alias");
constexpr size_t LIN_SCR = 16 * 2048 * 4 + 16 * 2048 * 2 + 16 * 32 * 4;
static_assert(LIN_SCR * 256 <= (size_t)MTOK * DM * 2, "lin scratch alias");

#define XB_TMO      128
#define XB_XCNT(j)  (256  + 64 * (j))
#define XB_XSUB(j)  (1280 + 64 * (j))
#define XB_XGEN(j)  (2304 + 64 * (j))
#define XB_TOP      3328
#define XB_TOPGEN   3392
#define XCD_BAR_WORDS 3456
#define XB_SPIN_CAP (1u << 20)

__device__ __forceinline__ unsigned xb_ld(unsigned* p)              { return __hip_atomic_load(p, __ATOMIC_RELAXED, __HIP_MEMORY_SCOPE_AGENT); }
__device__ __forceinline__ unsigned xb_add(unsigned* p, unsigned v) { return __hip_atomic_fetch_add(p, v, __ATOMIC_RELAXED, __HIP_MEMORY_SCOPE_AGENT); }
__device__ __forceinline__ unsigned xb_xcc_id() { return (unsigned)__builtin_amdgcn_s_getreg((3 << 11) | 20) & 0xFu; }
#define XB_SPIN(cond, bar) do { unsigned _sp = 0; while (cond) { __builtin_amdgcn_s_sleep(1); \
    if ((++_sp & 255u) == 0u) { if (xb_ld(&(bar)[XB_TMO])) break; if (_sp > XB_SPIN_CAP) { atomicAdd(&(bar)[XB_TMO], 1u); break; } } } } while (0)

struct XcdBarrier { unsigned* bar; unsigned x; volatile LAS unsigned* st; };

__device__ __forceinline__ XcdBarrier xcd_barrier_post(unsigned* bar, volatile LAS unsigned* st) {
    XcdBarrier b; b.bar = bar; b.x = xb_xcc_id(); b.st = st;
    if (threadIdx.x == 0) (void)xb_add(&bar[XB_XCNT(b.x)], 1u);
    return b;
}
__device__ __forceinline__ void xcd_barrier_complete(unsigned* bar, unsigned x, unsigned& nloc, unsigned& nx) {
    const unsigned G = gridDim.x * gridDim.y * gridDim.z;
    unsigned sum, cnt, mine, sp = 0u;
    for (;;) {
        sum = 0u; cnt = 0u; mine = 0u;
#pragma unroll
        for (unsigned j = 0; j < 16; ++j) { const unsigned c = xb_ld(&bar[XB_XCNT(j)]); sum += c; cnt += (c > 0u) ? 1u : 0u; mine = (j == x) ? c : mine; }
        if (sum == G) break;
        __builtin_amdgcn_s_sleep(1);
        if ((++sp & 255u) == 0u) { if (xb_ld(&bar[XB_TMO])) break; if (sp > XB_SPIN_CAP) { atomicAdd(&bar[XB_TMO], 1u); break; } }
    }
    nloc = mine > 0u ? mine : 1u; nx = cnt > 0u ? cnt : 1u;
}
__device__ __forceinline__ void xcd_barrier(const XcdBarrier& b) {
    asm volatile("s_waitcnt vmcnt(0)" ::: "memory");
    __syncthreads();
    if (threadIdx.x == 0) {
        unsigned* bar = b.bar;
        __builtin_amdgcn_s_waitcnt(0);
        unsigned nloc = b.st[0], nx = b.st[1];
        if (nloc == 0u) { xcd_barrier_complete(bar, b.x, nloc, nx); b.st[0] = nloc; b.st[1] = nx; }
        const unsigned old = xb_add(&bar[XB_XSUB(b.x)], 1u);
        const unsigned gen = old / nloc;
        if (old + 1u == (gen + 1u) * nloc) {
            __builtin_amdgcn_fence(__ATOMIC_RELEASE, "agent");
            asm volatile("s_waitcnt vmcnt(0)" ::: "memory");
            const unsigned og = xb_add(&bar[XB_TOP], 1u);
            const unsigned tg = og / nx;
            if (og + 1u == (tg + 1u) * nx) xb_add(&bar[XB_TOPGEN], 1u);
            else XB_SPIN(xb_ld(&bar[XB_TOPGEN]) == tg, bar);
            __builtin_amdgcn_fence(__ATOMIC_ACQUIRE, "agent");
            xb_add(&bar[XB_XGEN(b.x)], 1u);
            asm volatile("s_waitcnt vmcnt(0)" ::: "memory");
        } else {
            XB_SPIN(xb_ld(&bar[XB_XGEN(b.x)]) == gen, bar);
            __builtin_amdgcn_fence(__ATOMIC_ACQUIRE, "agent");
            asm volatile("s_waitcnt vmcnt(0)" ::: "memory");
        }
    }
    __syncthreads();
}

__device__ __forceinline__ unsigned cvtpk(float lo, float hi) { unsigned r; asm volatile("v_cvt_pk_bf16_f32 %0, %1, %2" : "=v"(r) : "v"(lo), "v"(hi)); return r; }
__device__ __forceinline__ float bf2f(bf16_t b) { return __uint_as_float(((unsigned)b) << 16); }
__device__ __forceinline__ float bflo(unsigned w) { return __uint_as_float(w << 16); }
__device__ __forceinline__ float bfhi(unsigned w) { return __uint_as_float(w & 0xffff0000u); }
__device__ __forceinline__ bf16_t f2bf(float f) { return (bf16_t)(cvtpk(f, f) & 0xffffu); }
__device__ __forceinline__ bf16x8 pack8(f32x4 a, f32x4 b) { u32x4 w = {cvtpk(a[0], a[1]), cvtpk(a[2], a[3]), cvtpk(b[0], b[1]), cvtpk(b[2], b[3])}; return *reinterpret_cast<bf16x8*>(&w); }
__device__ __forceinline__ int crow(int r, int hi) { return (r & 3) + 8 * (r >> 2) + 4 * hi; }
__device__ __forceinline__ float silu_f(float x) { return x * __builtin_amdgcn_rcpf(1.0f + __builtin_amdgcn_exp2f(-1.4426950408889634f * x)); }
__device__ __forceinline__ int ropedim(int p) { const int j = p >> 3, e = p & 7; return e < 4 ? 4 * j + e : 32 + 4 * j + (e - 4); }

__device__ __forceinline__ int ltid() { int t = threadIdx.x; asm volatile("" : "+v"(t)); return t; }
struct Params {
    const float* in[19]; float* out; unsigned char* ws; int ph_lo, ph_hi;
};

namespace pg8 {
constexpr int BM = 256, BK = 64, HALF = 128, HTB = HALF * BK * 2, STAGE_BYTES = 8 * HTB, NXCD = 8, WGM = 8;
__host__ __device__ __forceinline__ int lds_byte(int r, int c) { const int st = (r >> 4) * 2 + (c >> 5), rr = r & 15, cc = c & 31, ob = rr * 64 + cc * 2; return st * 1024 + (ob ^ (((ob >> 9) & 1) << 5)); }
__host__ __device__ __forceinline__ void stage_rc(int b, int& R, int& C) { const int st = b / 1024, sb = b % 1024, swz = sb ^ (((sb >> 9) & 1) << 5); R = (st >> 1) * 16 + swz / 64; C = (st & 1) * 32 + (swz % 64) / 2; }
__host__ __device__ __forceinline__ int perm32(int rho) { const int n = rho >> 4, i = rho & 15; return 8 * (i >> 2) + 4 * n + (i & 3); }
struct Unit { int pm, pn; };
struct Gemm { const bf16_t* A; const bf16_t* Bt; int lda, ldb, K; };
struct StaticOrder {
    int nM, nN, nwg, G, c, imax, pn0;
    __device__ void init(int nM_, int nN_, int G_, int c_) { nM = nM_; nN = nN_; nwg = nM * nN; G = G_; c = c_; imax = 1 << 30; pn0 = 0; }
    __device__ bool next(int i, Unit& u) const {
        const long L = (long)i * G + c; if (i >= imax || L >= nwg) return false;
        int wgid = (int)L; { const int q = nwg / NXCD, r = nwg % NXCD, xcd = wgid % NXCD, off = wgid / NXCD; wgid = (xcd < r ? xcd * (q + 1) : r * (q + 1) + (xcd - r) * q) + off; }
        const int nig = WGM * nN, gid = wgid / nig, fm = gid * WGM, gsz = (nM - fm) < WGM ? (nM - fm) : WGM;
        u.pm = fm + ((wgid % nig) % gsz); u.pn = (wgid % nig) / gsz + pn0; return true;
    }
};
__device__ __forceinline__ void rowsum_out(LAS unsigned char* xl, const float (&sA)[2][4], const float (&sB)[2][4], int wr, int wc, int fr, int fq,
                                           float* dA, int strA, float* dB, int strB, int row0) {
    LAS float* X = (LAS float*)xl;
#pragma unroll
    for (int ai = 0; ai < 2; ++ai)
#pragma unroll
        for (int m = 0; m < 4; ++m) {
            float a = sA[ai][m], b = sB[ai][m];
            a += __shfl_xor(a, 16); a += __shfl_xor(a, 32); b += __shfl_xor(b, 16); b += __shfl_xor(b, 32);
            const int rl = ai * 128 + wr * 64 + m * 16 + fr;
            if (fq == 0) { X[rl * 4 + wc] = a; X[(256 + rl) * 4 + wc] = b; }
        }
    asm volatile("s_waitcnt lgkmcnt(0)" ::: "memory"); __builtin_amdgcn_s_barrier(); asm volatile("" ::: "memory");
    const int t = ltid() & 255, s = t >> 7, rr = t & 127, rl = (rr >> 6) * 128 + wr * 64 + (rr & 63);
    const f32x4 v = *(const LAS f32x4*)(X + (s * 256 + rl) * 4);
    const float tot = (v[0] + v[1]) + (v[2] + v[3]);
    if (s == 0) { if (dA) dA[(size_t)(row0 + rl) * strA] = tot; } else { if (dB) dB[(size_t)(row0 + rl) * strB] = tot; }
}

struct EpiZ {
    bf16_t* Z; bf16_t* KR; const float* ssqx; float* ssqq; float* ssqkv; const float* rc; const float* rs; LAS unsigned char* xl; int skip;
    static constexpr int STAT_N = 4; static constexpr float STAT_INV = 1.0f / 1024.0f;
    __device__ __forceinline__ const float* stat() const { return ssqx; }
    __device__ __forceinline__ void operator()(f32x4 (&acc)[2][2][4][2], const Unit& u, int wr, int wc, int fr, int fq, const LAS f32x4* rs_) const {
        if (REP_MASK && skip) return;
        float sA[2][4], sB[2][4], rstd[2][4];
        const bool krope = (u.pn == 2) && (wc < 2);
        const int row0 = u.pm * BM + wr * 64 + fr, jq = 4 * wc + fq;
#pragma unroll
        for (int ai = 0; ai < 2; ++ai)
#pragma unroll
            for (int m = 0; m < 4; ++m) { const f32x4 q = rs_[ai * HALF + wr * 64 + m * 16 + fr]; rstd[ai][m] = __builtin_amdgcn_rsqf(((q[0] + q[1]) + (q[2] + q[3])) * (1.0f / 1024.0f) + EPS); }
        f32x4 cn = (f32x4){0.f, 0.f, 0.f, 0.f}, sn = cn;
        if (krope) { const int pos = row0 & (SEQ - 1); cn = *(const f32x4*)(rc + pos * 32 + 4 * jq); sn = *(const f32x4*)(rs + pos * 32 + 4 * jq); }
#pragma unroll
        for (int ai = 0; ai < 2; ++ai)
#pragma unroll
            for (int m = 0; m < 4; ++m) {
                const int row = row0 + ai * HALF + m * 16;
                const f32x4 c = cn, sv = sn;
                if (krope && !(ai == 1 && m == 3)) { const int nrow = row0 + ((ai * 4 + m + 1) >> 2) * HALF + ((m + 1) & 3) * 16, pos = nrow & (SEQ - 1);
                    cn = *(const f32x4*)(rc + pos * 32 + 4 * jq); sn = *(const f32x4*)(rs + pos * 32 + 4 * jq); }
                float ss[2];
#pragma unroll
                for (int bj = 0; bj < 2; ++bj) {
                    f32x4 v0 = acc[ai][bj][m][0] * rstd[ai][m], v1 = acc[ai][bj][m][1] * rstd[ai][m];
                    ss[bj] = (v0[0] * v0[0] + v0[1] * v0[1]) + (v0[2] * v0[2] + v0[3] * v0[3]) + (v1[0] * v1[0] + v1[1] * v1[1]) + (v1[2] * v1[2] + v1[3] * v1[3]);
                    const int col = u.pn * BM + bj * HALF + wc * 32 + 8 * fq;
                    if (bj == 1 && krope) {
                        const f32x4 o1 = v0 * c - v1 * sv, o2 = v1 * c + v0 * sv;
                        *(bf16x8*)(KR + (size_t)row * 64 + (col - ZC_KR)) = pack8(o1, o2);
                    } else {
                        *(bf16x8*)(Z + (size_t)row * NZ + col) = pack8(v0, v1);
                    }
                }
                sA[ai][m] = (u.pn == 0) ? ss[0] + ss[1] : ss[0]; sB[ai][m] = ss[1];
                __builtin_amdgcn_sched_barrier(0);
            }
        if (u.pn <= 2) {
            float* dA = (u.pn == 0) ? ssqq : (u.pn == 1 ? ssqq + 1 : ssqkv + 1);
            float* dB = (u.pn == 1) ? ssqkv : nullptr;
            rowsum_out(xl, sA, sB, wr, wc, fr, fq, dA, 4, dB, 4, u.pm * BM);
        }
    }
};
struct EpiQ {
    bf16_t* Q; const float* ssqq; const float* rc; const float* rs;
    static constexpr int STAT_N = 4; static constexpr float STAT_INV = 1.0f / 384.0f;
    __device__ __forceinline__ const float* stat() const { return ssqq; }
    __device__ __forceinline__ void operator()(f32x4 (&acc)[2][2][4][2], const Unit& u, int wr, int wc, int fr, int fq, const LAS f32x4* rs_) const {
        float rstd[2][4];
        const int row0 = u.pm * BM + wr * 64 + fr, jq = 4 * (wc & 1) + fq;
        const bool rp0 = ((4 * u.pn + (wc >> 1)) % 3) == 2, rp1 = ((4 * u.pn + 2 + (wc >> 1)) % 3) == 2, anyrope = rp0 || rp1;
#pragma unroll
        for (int ai = 0; ai < 2; ++ai)
#pragma unroll
            for (int m = 0; m < 4; ++m) { const f32x4 q = rs_[ai * HALF + wr * 64 + m * 16 + fr]; rstd[ai][m] = __builtin_amdgcn_rsqf((q[0] + q[1]) * (1.0f / 384.0f) + EPS); }
        f32x4 cn = (f32x4){0.f, 0.f, 0.f, 0.f}, sn = cn;
        if (anyrope) { const int pos = row0 & (SEQ - 1); cn = *(const f32x4*)(rc + pos * 32 + 4 * jq); sn = *(const f32x4*)(rs + pos * 32 + 4 * jq); }
#pragma unroll
        for (int ai = 0; ai < 2; ++ai)
#pragma unroll
            for (int m = 0; m < 4; ++m) {
                const int row = row0 + ai * HALF + m * 16;
                const f32x4 c = cn, sv = sn;
                if (anyrope && !(ai == 1 && m == 3)) { const int nrow = row0 + ((ai * 4 + m + 1) >> 2) * HALF + ((m + 1) & 3) * 16, pos = nrow & (SEQ - 1);
                    cn = *(const f32x4*)(rc + pos * 32 + 4 * jq); sn = *(const f32x4*)(rs + pos * 32 + 4 * jq); }
#pragma unroll
                for (int bj = 0; bj < 2; ++bj) {
                    f32x4 v0 = acc[ai][bj][m][0] * rstd[ai][m], v1 = acc[ai][bj][m][1] * rstd[ai][m];
                    const int col = u.pn * BM + bj * HALF + wc * 32 + 8 * fq;
                    if (bj == 0 ? rp0 : rp1) { const f32x4 o1 = v0 * c - v1 * sv, o2 = v1 * c + v0 * sv; v0 = o1; v1 = o2; }
                    *(bf16x8*)(Q + (size_t)row * NQ + col) = pack8(v0, v1);
                }
                __builtin_amdgcn_sched_barrier(0);
            }
    }
};
struct EpiKV {
    bf16_t* KV; const float* ssqkv;
    static constexpr int STAT_N = 4; static constexpr float STAT_INV = 1.0f / 256.0f;
    __device__ __forceinline__ const float* stat() const { return ssqkv - 2; }
    __device__ __forceinline__ void operator()(f32x4 (&acc)[2][2][4][2], const Unit& u, int wr, int wc, int fr, int fq, const LAS f32x4* rs_) const {
        float rstd[2][4];
        const int row0 = u.pm * BM + wr * 64 + fr;
#pragma unroll
        for (int ai = 0; ai < 2; ++ai)
#pragma unroll
            for (int m = 0; m < 4; ++m) { const f32x4 q = rs_[ai * HALF + wr * 64 + m * 16 + fr]; rstd[ai][m] = __builtin_amdgcn_rsqf((q[2] + q[3]) * (1.0f / 256.0f) + EPS); }
#pragma unroll
        for (int ai = 0; ai < 2; ++ai)
#pragma unroll
            for (int m = 0; m < 4; ++m) {
                const int row = row0 + ai * HALF + m * 16;
#pragma unroll
                for (int bj = 0; bj < 2; ++bj) {
                    const int col = u.pn * BM + bj * HALF + wc * 32 + 8 * fq;
                    *(bf16x8*)(KV + (size_t)row * NKV + col) = pack8(acc[ai][bj][m][0] * rstd[ai][m], acc[ai][bj][m][1] * rstd[ai][m]);
                }
                __builtin_amdgcn_sched_barrier(0);
            }
    }
};
struct EpiRes {
    bf16_t* XB; float* ssqx; LAS unsigned char* xl; float sc;
    static constexpr int STAT_N = 0; static constexpr float STAT_INV = 0.f;
    __device__ __forceinline__ const float* stat() const { return nullptr; }
    __device__ __forceinline__ void operator()(f32x4 (&acc)[2][2][4][2], const Unit& u, int wr, int wc, int fr, int fq, const LAS f32x4*) const {
        float sA[2][4], sB[2][4];
        if (REP_MASK && sc < 0.f) return;
        const size_t o0 = (size_t)(u.pm * BM + wr * 64 + fr) * DM + u.pn * BM + wc * 32 + 8 * fq;
#ifndef RES_DEPTH
#define RES_DEPTH 4
#endif
        u32x4 nx[RES_DEPTH][2];
#pragma unroll
        for (int k = 0; k < RES_DEPTH; ++k)
#pragma unroll
            for (int bj = 0; bj < 2; ++bj) nx[k][bj] = *(const u32x4*)(XB + o0 + (size_t)((k >> 2) * HALF + (k & 3) * 16) * DM + bj * HALF);
#pragma unroll
        for (int ai = 0; ai < 2; ++ai)
#pragma unroll
            for (int m = 0; m < 4; ++m) {
                const int k = ai * 4 + m;
                const size_t orow = o0 + (size_t)(ai * HALF + m * 16) * DM;
                u32x4 cx[2];
#pragma unroll
                for (int bj = 0; bj < 2; ++bj) cx[bj] = nx[k % RES_DEPTH][bj];
                if (k + RES_DEPTH < 8) { const int kn = k + RES_DEPTH;
#pragma unroll
                    for (int bj = 0; bj < 2; ++bj) nx[k % RES_DEPTH][bj] = *(const u32x4*)(XB + o0 + (size_t)((kn >> 2) * HALF + (kn & 3) * 16) * DM + bj * HALF); }
                float ss = 0.f;
#pragma unroll
                for (int bj = 0; bj < 2; ++bj) {
                    const f32x4 x0 = (f32x4){bflo(cx[bj][0]), bfhi(cx[bj][0]), bflo(cx[bj][1]), bfhi(cx[bj][1])}, x1 = (f32x4){bflo(cx[bj][2]), bfhi(cx[bj][2]), bflo(cx[bj][3]), bfhi(cx[bj][3])};
                    const f32x4 v0 = x0 + acc[ai][bj][m][0] * sc, v1 = x1 + acc[ai][bj][m][1] * sc;
                    *(bf16x8*)(XB + orow + bj * HALF) = pack8(v0, v1);
                    ss += (v0[0] * v0[0] + v0[1] * v0[1]) + (v0[2] * v0[2] + v0[3] * v0[3]) + (v1[0] * v1[0] + v1[1] * v1[1]) + (v1[2] * v1[2] + v1[3] * v1[3]);
                }
                sA[ai][m] = ss; sB[ai][m] = 0.f;
                __builtin_amdgcn_sched_barrier(0);
            }
        rowsum_out(xl, sA, sB, wr, wc, fr, fq, ssqx + u.pn, 4, nullptr, 0, u.pm * BM);
    }
};
__device__ __forceinline__ float dpp_ror1(float v) { return __int_as_float(__builtin_amdgcn_mov_dpp(__float_as_int(v), 0x121, 0xf, 0xf, false)); }
__device__ __forceinline__ float dpp_ror2(float v) { return __int_as_float(__builtin_amdgcn_mov_dpp(__float_as_int(v), 0x122, 0xf, 0xf, false)); }
__device__ __forceinline__ float dpp_shr1(float old, float v) { return __int_as_float(__builtin_amdgcn_update_dpp(__float_as_int(old), __float_as_int(v), 0x111, 0xf, 0xf, false)); }
__device__ __forceinline__ float dpp_shr2(float old, float v) { return __int_as_float(__builtin_amdgcn_update_dpp(__float_as_int(old), __float_as_int(v), 0x112, 0xf, 0xf, false)); }
struct EpiUp {
    bf16_t* G; const float* ssqx; const float* cw; const float* cb; float* halo; float* heada; float* headb; LAS unsigned char* xl; int skip;
    static constexpr int STAT_N = 4; static constexpr float STAT_INV = 1.0f / 1024.0f;
    __device__ __forceinline__ const float* stat() const { return ssqx; }
    __device__ __forceinline__ void operator()(f32x4 (&acc)[2][2][4][2], const Unit& u, int wr, int wc, int fr, int fq, const LAS f32x4* rs_) const {
        if (REP_MASK && skip) return;
        LAS float* EX = (LAS float*)(xl + 8192);
        const int cbase = u.pn * HALF + wc * 32 + 8 * fq;
        f32x4 w0[2], w1[2], w2[2], bb[2];
#pragma unroll
        for (int n = 0; n < 2; ++n) { w0[n] = *(const f32x4*)(cw + cbase + 4 * n); w1[n] = *(const f32x4*)(cw + DFF + cbase + 4 * n); w2[n] = *(const f32x4*)(cw + 2 * DFF + cbase + 4 * n); bb[n] = *(const f32x4*)(cb + cbase + 4 * n); }
#pragma unroll
        for (int ai = 0; ai < 2; ++ai)
#pragma unroll
            for (int m = 0; m < 4; ++m) {
                const f32x4 q = rs_[ai * HALF + wr * 64 + m * 16 + fr];
                const float rstd = __builtin_amdgcn_rsqf(((q[0] + q[1]) + (q[2] + q[3])) * (1.0f / 1024.0f) + EPS);
#pragma unroll
                for (int bj = 0; bj < 2; ++bj) { acc[ai][bj][m][0] *= rstd; acc[ai][bj][m][1] *= rstd; }
            }
#pragma unroll
        for (int ai = 0; ai < 2; ++ai)
            if (fr >= 14) { LAS float* e = EX + ((((ai * 2 + wr) * 4 + wc) * 2 + (fr - 14)) * 32 + 8 * fq); *(LAS f32x4*)e = acc[ai][0][3][0]; *(LAS f32x4*)(e + 4) = acc[ai][0][3][1]; }
        asm volatile("s_waitcnt lgkmcnt(0)" ::: "memory"); __builtin_amdgcn_s_barrier(); asm volatile("" ::: "memory");
        __builtin_amdgcn_s_barrier(); asm volatile("" ::: "memory");
#pragma unroll
        for (int ai = 0; ai < 2; ++ai) {
            f32x4 pv[2];
            if (wr == 1 || ai == 1) {
                const int sai = (wr == 1) ? ai : 0, swr = (wr == 1) ? 0 : 1;
                const LAS float* e = EX + ((((sai * 2 + swr) * 4 + wc) * 2 + ((fr - 14) & 1)) * 32 + 8 * fq);
                pv[0] = *(const LAS f32x4*)e; pv[1] = *(const LAS f32x4*)(e + 4);
            } else { pv[0] = (f32x4){0.f, 0.f, 0.f, 0.f}; pv[1] = pv[0]; }
#pragma unroll
            for (int m = 0; m < 4; ++m) {
                const int row = u.pm * BM + ai * HALF + wr * 64 + m * 16 + fr;
                f32x4 gv[2];
#pragma unroll
                for (int n = 0; n < 2; ++n)
#pragma unroll
                    for (int j = 0; j < 4; j += 2) {
                        const f32x2 cur = {acc[ai][0][m][n][j], acc[ai][0][m][n][j + 1]};
                        const f32x2 u1 = {dpp_shr1(dpp_ror1(pv[n][j]), cur[0]), dpp_shr1(dpp_ror1(pv[n][j + 1]), cur[1])};
                        const f32x2 u2 = {dpp_shr2(dpp_ror2(pv[n][j]), cur[0]), dpp_shr2(dpp_ror2(pv[n][j + 1]), cur[1])};
                        const f32x2 W0 = {w0[n][j], w0[n][j + 1]}, W1 = {w1[n][j], w1[n][j + 1]}, W2 = {w2[n][j], w2[n][j + 1]}, BB = {bb[n][j], bb[n][j + 1]};
                        const f32x2 cv = __builtin_elementwise_fma(W2, cur, __builtin_elementwise_fma(W1, u1, __builtin_elementwise_fma(W0, u2, BB)));
                        const f32x2 tt = cv * -1.4426950408889634f;
                        f32x2 ee; ee[0] = __builtin_amdgcn_exp2f(tt[0]); ee[1] = __builtin_amdgcn_exp2f(tt[1]);
                        const f32x2 dd = ee + 1.0f;
                        f32x2 rr; rr[0] = __builtin_amdgcn_rcpf(dd[0]); rr[1] = __builtin_amdgcn_rcpf(dd[1]);
                        const f32x2 bq = {acc[ai][1][m][n][j], acc[ai][1][m][n][j + 1]};
                        const f32x2 g2 = (cv * rr) * bq;
                        gv[n][j] = g2[0]; gv[n][j + 1] = g2[1];
                    }
                const bool head = (ai == 0 && wr == 0 && m == 0 && fr < 2);
                if (!head) *(bf16x8*)(G + (size_t)row * DFF + cbase) = pack8(gv[0], gv[1]);
                else {
                    float* ha = heada + ((size_t)(u.pm * 2 + fr) * DFF + cbase); float* hb = headb + ((size_t)(u.pm * 2 + fr) * DFF + cbase);
                    *(f32x4*)ha = acc[0][0][0][0]; *(f32x4*)(ha + 4) = acc[0][0][0][1]; *(f32x4*)hb = acc[0][1][0][0]; *(f32x4*)(hb + 4) = acc[0][1][0][1];
                }
                if (ai == 1 && wr == 1 && m == 3 && fr >= 14) {
                    float* hl = halo + ((size_t)(u.pm * 2 + (fr - 14)) * DFF + cbase);
                    *(f32x4*)hl = acc[1][0][3][0]; *(f32x4*)(hl + 4) = acc[1][0][3][1];
                }
                pv[0] = acc[ai][0][m][0]; pv[1] = acc[ai][0][m][1];
                __builtin_amdgcn_sched_barrier(0);
            }
        }
    }
};

template <class Epi, class Sched>
__device__ __forceinline__ void gemm_phase(LAS unsigned char* lds, const Gemm g, const Sched& S, const Epi& E, LAS float* rsl) {
    int tid = threadIdx.x; asm volatile("" : "+v"(tid));
    const int wid = __builtin_amdgcn_readfirstlane(tid >> 6), lane = tid & 63, wr = wid >> 2, wc = wid & 3, fr = lane & 15, fq = lane >> 4;
    const int K = g.K, nt = K / BK;
    unsigned voffA[2], voffB[2];
#pragma unroll
    for (int i = 0; i < 2; ++i) { int R, C; stage_rc(tid * 16 + i * 8192, R, C); const int Rb = (R & ~31) + perm32(R & 31);
        voffA[i] = (unsigned)(R * g.lda + C) * 2u; voffB[i] = (unsigned)(Rb * g.ldb + C) * 2u; }
    const size_t kstep = (size_t)(BK * 2);
    const size_t hstepA = (size_t)HALF * g.lda * 2, hstepB = (size_t)HALF * g.ldb * 2;
    const size_t tstepA = 2 * hstepA, tstepB = 2 * hstepB;
    const unsigned ldsw = (unsigned)wid * 1024u;
    const int aoff = lds_byte(wr * 64 + fr, fq * 8), boff = lds_byte(wc * 32 + fr, fq * 8);
#define PG8_SA(b, h) (((b) * 2 + (h)) * HTB)
#define PG8_SB(b, h) ((4 + (b) * 2 + (h)) * HTB)
#define PG8_STAGE(bufoff, gbase, voff) do { _Pragma("unroll") for (int _i = 0; _i < 2; ++_i) \
        __builtin_amdgcn_global_load_lds((const unsigned*)((const char*)(gbase) + (voff)[_i]), (LAS unsigned*)(lds + (bufoff) + ldsw + _i * 8192), 16, 0, 0); } while (0)
#define PG8_LDA(dst, b, h) do { _Pragma("unroll") for (int m = 0; m < 4; ++m) _Pragma("unroll") for (int k = 0; k < 2; ++k) dst[m][k] = *(const LAS bf16x8*)(lds + PG8_SA(b, h) + aoff + m * 2048 + k * 1024); } while (0)
#define PG8_LDB(dst, b, h) do { _Pragma("unroll") for (int n = 0; n < 2; ++n) _Pragma("unroll") for (int k = 0; k < 2; ++k) dst[n][k] = *(const LAS bf16x8*)(lds + PG8_SB(b, h) + boff + n * 2048 + k * 1024); } while (0)
#define PG8_MMA(ai, bj, At, Bt) do { __builtin_amdgcn_s_setprio(1); _Pragma("unroll") for (int m = 0; m < 4; ++m) _Pragma("unroll") for (int n = 0; n < 2; ++n) _Pragma("unroll") for (int k = 0; k < 2; ++k) \
        acc[ai][bj][m][n] = __builtin_amdgcn_mfma_f32_16x16x32_bf16(Bt[n][k], At[m][k], acc[ai][bj][m][n], 0, 0, 0); __builtin_amdgcn_s_setprio(0); } while (0)
#define PG8_WAIT_V(n) asm volatile("s_waitcnt vmcnt(" #n ")" ::: "memory")
#define PG8_WAIT_L(n) asm volatile("s_waitcnt lgkmcnt(" #n ")" ::: "memory")
#define PG8_BAR __builtin_amdgcn_s_barrier()
#define PG8_SCHED __builtin_amdgcn_sched_barrier(0)
    Unit cur, nxt; int ui = 0;
    if (!S.next(0, cur)) return;
    f32x4 acc[2][2][4][2];
#pragma unroll
    for (int a = 0; a < 2; ++a)
#pragma unroll
        for (int b = 0; b < 2; ++b)
#pragma unroll
            for (int m = 0; m < 4; ++m)
#pragma unroll
                for (int n = 0; n < 2; ++n) acc[a][b][m][n] = (f32x4){0.f, 0.f, 0.f, 0.f};
    bf16x8 At[4][2], B0[2][2], B1[2][2];
    const char* cA = (const char*)g.A + (size_t)cur.pm * tstepA; const char* cB = (const char*)g.Bt + (size_t)cur.pn * tstepB;
#define PG8_STAT_DMA(pm_, bu_) do { if (Epi::STAT_N && wid < 4) __builtin_amdgcn_global_load_lds((const unsigned*)(E.stat() + (size_t)((pm_) * BM + tid) * 4), \
        (LAS unsigned*)((LAS unsigned char*)rsl + (bu_) * 4096 + wid * 1024), 16, 0, 0); } while (0)
    PG8_STAT_DMA(cur.pm, 0);
    PG8_STAGE(PG8_SB(0, 0), cB, voffB); PG8_STAGE(PG8_SA(0, 0), cA, voffA); PG8_STAGE(PG8_SB(0, 1), cB + hstepB, voffB); PG8_STAGE(PG8_SA(0, 1), cA + hstepA, voffA);
    if (wr == 1) PG8_BAR;
    PG8_WAIT_V(4); PG8_BAR;
    PG8_STAGE(PG8_SB(1, 0), cB + kstep, voffB); PG8_STAGE(PG8_SA(1, 0), cA + kstep, voffA); PG8_STAGE(PG8_SB(1, 1), cB + hstepB + kstep, voffB);
    PG8_WAIT_V(6); PG8_BAR;
    for (;;) {
        const bool has_next = S.next(ui + 1, nxt);
        if (has_next) PG8_STAT_DMA(nxt.pm, (ui + 1) % 3);
        const char* nA = has_next ? (const char*)g.A + (size_t)nxt.pm * tstepA : cA; const char* nB = has_next ? (const char*)g.Bt + (size_t)nxt.pn * tstepB : cB;
#pragma nounroll
        for (int t = 0; t < nt; t += 2) {
            const bool last = (t == nt - 2);
            const char* a1 = cA + (size_t)(t + 1) * kstep;
            const char* a2 = last ? nA : cA + (size_t)(t + 2) * kstep; const char* b2 = last ? nB : cB + (size_t)(t + 2) * kstep;
            const char* a3 = a2 + kstep; const char* b3 = b2 + kstep;
            PG8_LDB(B0, 0, 0); PG8_SCHED; PG8_LDA(At, 0, 0); PG8_STAGE(PG8_SA(1, 1), a1 + hstepA, voffA);
            PG8_WAIT_L(8); PG8_BAR; PG8_WAIT_L(0); PG8_MMA(0, 0, At, B0); PG8_BAR; PG8_SCHED;
            PG8_LDB(B1, 0, 1); PG8_STAGE(PG8_SB(0, 0), b2, voffB);
            PG8_BAR; PG8_WAIT_L(0); PG8_MMA(0, 1, At, B1); PG8_BAR;
            PG8_LDA(At, 0, 1); PG8_STAGE(PG8_SA(0, 0), a2, voffA);
            PG8_BAR; PG8_WAIT_L(0); PG8_MMA(1, 0, At, B0); PG8_BAR; PG8_SCHED;
            PG8_STAGE(PG8_SB(0, 1), b2 + hstepB, voffB);
            PG8_WAIT_V(6); PG8_BAR; PG8_MMA(1, 1, At, B1); PG8_BAR;
            PG8_LDB(B0, 1, 0); PG8_SCHED; PG8_LDA(At, 1, 0); PG8_STAGE(PG8_SA(0, 1), a2 + hstepA, voffA);
            PG8_WAIT_L(8); PG8_BAR; PG8_WAIT_L(0); PG8_MMA(0, 0, At, B0); PG8_BAR; PG8_SCHED;
            PG8_LDB(B1, 1, 1); PG8_STAGE(PG8_SB(1, 0), b3, voffB);
            PG8_BAR; PG8_WAIT_L(0); PG8_MMA(0, 1, At, B1); PG8_BAR;
            PG8_LDA(At, 1, 1); PG8_STAGE(PG8_SA(1, 0), a3, voffA);
            PG8_BAR; PG8_WAIT_L(0); PG8_MMA(1, 0, At, B0); PG8_BAR; PG8_SCHED;
            PG8_STAGE(PG8_SB(1, 1), b3 + hstepB, voffB);
            PG8_WAIT_V(6); PG8_BAR; PG8_MMA(1, 1, At, B1); PG8_BAR;
        }
        { int t_ = tid; asm volatile("" : "+v"(t_));
          E(acc, cur, wr, wc, t_ & 15, (t_ & 63) >> 4, (const LAS f32x4*)rsl + (ui % 3) * 256); }
        if (!has_next) break;
#pragma unroll
        for (int a = 0; a < 2; ++a)
#pragma unroll
            for (int b = 0; b < 2; ++b)
#pragma unroll
                for (int m = 0; m < 4; ++m)
#pragma unroll
                    for (int n = 0; n < 2; ++n) acc[a][b][m][n] = (f32x4){0.f, 0.f, 0.f, 0.f};
        cur = nxt; cA = nA; cB = nB; ++ui;
    }
    PG8_WAIT_V(0);
    if (wr == 0) PG8_BAR;
    PG8_BAR;
#undef PG8_STAT_DMA
#undef PG8_SA
#undef PG8_SB
#undef PG8_STAGE
#undef PG8_LDA
#undef PG8_LDB
#undef PG8_MMA
#undef PG8_WAIT_V
#undef PG8_WAIT_L
#undef PG8_BAR
#undef PG8_SCHED
}
}

__device__ __forceinline__ int srccol(int kind, int n) {
    if (kind == 0) { if (n >= ZC_PAD && n < ZC_RG) return -1; if (n >= ZC_RG) return n - (ZC_RG - ZC_PAD); if (n >= ZC_KR && n < ZC_KR + 64) return ZC_KR + ropedim(n - ZC_KR); return n; }
    if (kind == 1) { const int h = n / 192, w = n % 192; return w < 128 ? n : h * 192 + 128 + ropedim(w - 128); }
    if (kind == 4) { const int pn = n >> 8, w = n & 255; return w < 128 ? 128 * pn + w : DFF + 128 * pn + (w - 128); }
    return n;
}
__device__ __forceinline__ int tile_src0(int kind, int n0) {
    if (kind == 4) { const int pn = n0 >> 8, w = n0 & 255; return w < 128 ? 128 * pn + w : DFF + 128 * pn + (w - 128); }
    if (kind == 0 && n0 >= ZC_RG) return n0 - (ZC_RG - ZC_PAD);
    return n0;
}
__device__ __forceinline__ bool tile_is_rope(int kind, int n0) { return (kind == 0 && n0 == ZC_KR) || (kind == 1 && (n0 % 192) == 128); }
struct WTile { const float* src; const float* gain; bf16_t* dst; int K, nsrc, n0, k0, s0, ncols; float scale; bool rope; };
__device__ __forceinline__ void wtile_decode(const Params& p, int it, WTile& t) {
    constexpr int TN[6] = {NZ / 64, NQ / 64, NKV / 64, DM / 64, NUP / 64, DM / 64};
    constexpr int TK[6] = {DM / 64, 384 / 64, 256 / 64, DM / 64, DM / 64, DFF / 64};
    constexpr int NSRC[6] = {ZC_END, NQ, NKV, DM, NUP, DM};
    constexpr size_t WOFF[6] = {W_IN, W_UQ, W_UKV, W_OUT, W_UP, W_DN};
    constexpr int SRCI[6] = {2, 4, 6, 12, 14, 17};
    constexpr int GAINI[6] = {1, 3, 5, -1, 13, -1};
    int cum[7]; cum[0] = 0;
#pragma unroll
    for (int k = 0; k < 6; ++k) cum[k + 1] = cum[k] + TN[k] * TK[k];
    const int per_layer = cum[6];
    const int l = it / per_layer; int r = it % per_layer, kind = 0;
#pragma unroll
    for (int k = 1; k < 6; ++k) if (r >= cum[k]) kind = k;
    int tk = 0, nsrc = 0, gi = -1, si = 0; size_t woff = 0;
#pragma unroll
    for (int k = 0; k < 6; ++k) if (kind == k) { r -= cum[k]; tk = TK[k]; nsrc = NSRC[k]; gi = GAINI[k]; si = SRCI[k]; woff = WOFF[k]; }
    t.K = tk * 64; t.nsrc = nsrc; t.n0 = (r / tk) * 64; t.k0 = (r % tk) * 64;
    t.src = p.in[si] + (size_t)l * t.K * nsrc; t.gain = gi >= 0 ? p.in[gi] + (size_t)l * t.K : nullptr;
    if (kind == 3) t.gain = t.k0 < 512 ? p.in[7] + l * 512 : (t.k0 < 768 ? p.in[10] + l * 256 - 512 : p.in[11] + l * 256 - 768);
    t.scale = (kind == 1) ? 0.10411755f   : 1.0f;
    t.dst = (bf16_t*)(p.ws + WS_W + (size_t)l * W_LAYER + woff);
    t.s0 = tile_src0(kind, t.n0); t.rope = tile_is_rope(kind, t.n0);
    t.ncols = (nsrc - t.s0) < 64 ? (nsrc - t.s0) : 64;
    if (kind == 0 && t.n0 < ZC_RG) t.ncols = (ZC_PAD - t.n0) < 64 ? (ZC_PAD - t.n0) : 64;
}
__device__ __forceinline__ void prologue(const Params& p, lptr lds) {
    const int tid = ltid(), G = gridDim.x, wg = blockIdx.x;
    LAS float* tile = (LAS float*)lds;
    constexpr int PER_LAYER = (NZ / 64) * (DM / 64) + (NQ / 64) * 6 + (NKV / 64) * 4 + (DM / 64) * (DM / 64) + (NUP / 64) * (DM / 64) + (DM / 64) * (DFF / 64);
    const int NT = PER_LAYER * DEPTH;
    const int lk = tid >> 4, ln = (tid & 15) * 4;
    const int sn = tid >> 3, sk = (tid & 7) * 8;
    WTile t; f32x4 v0, v1; float g0 = 1.f, g1 = 1.f;
    int it = wg;
    if (it < NT) {
        wtile_decode(p, it, t);
        const bool ok = ln < t.ncols;
        v0 = ok ? *(const f32x4*)(t.src + (size_t)(t.k0 + lk) * t.nsrc + t.s0 + ln) : (f32x4){0.f, 0.f, 0.f, 0.f};
        v1 = ok ? *(const f32x4*)(t.src + (size_t)(t.k0 + lk + 32) * t.nsrc + t.s0 + ln) : (f32x4){0.f, 0.f, 0.f, 0.f};
        if (t.gain) { g0 = t.gain[t.k0 + lk]; g1 = t.gain[t.k0 + lk + 32]; }
    }
    while (it < NT) {
        const WTile c = t; const f32x4 c0 = v0 * (g0 * c.scale), c1 = v1 * (g1 * c.scale);
        const int nit = it + G;
        if (nit < NT) {
            wtile_decode(p, nit, t);
            const bool ok = ln < t.ncols;
            v0 = ok ? *(const f32x4*)(t.src + (size_t)(t.k0 + lk) * t.nsrc + t.s0 + ln) : (f32x4){0.f, 0.f, 0.f, 0.f};
            v1 = ok ? *(const f32x4*)(t.src + (size_t)(t.k0 + lk + 32) * t.nsrc + t.s0 + ln) : (f32x4){0.f, 0.f, 0.f, 0.f};
            g0 = 1.f; g1 = 1.f; if (t.gain) { g0 = t.gain[t.k0 + lk]; g1 = t.gain[t.k0 + lk + 32]; }
        }
        __syncthreads();
#pragma unroll
        for (int j = 0; j < 4; ++j) { tile[lk * 65 + ln + j] = c0[j]; tile[(lk + 32) * 65 + ln + j] = c1[j]; }
        __syncthreads();
        { const int scol = c.rope ? ropedim(sn) : sn;
          f32x4 a, b;
#pragma unroll
          for (int j = 0; j < 4; ++j) { a[j] = tile[(sk + j) * 65 + scol]; b[j] = tile[(sk + 4 + j) * 65 + scol]; }
          *(bf16x8*)(c.dst + (size_t)(c.n0 + sn) * c.K + c.k0 + sk) = pack8(a, b); }
        it = nit;
    }
    __syncthreads();
    { const float* x = p.in[0]; bf16_t* XB = (bf16_t*)(p.ws + WS_XB); float* ssqx = (float*)(p.ws + WS_SSQX);
      const int lane = tid & 63, wv = tid >> 6;
      for (int row = wg * 8 + wv; row < MTOK; row += G * 8) {
          float ss = 0.f;
#pragma unroll
          for (int i = 0; i < 2; ++i) { const size_t o = (size_t)row * DM + i * 512 + lane * 8;
              const f32x4 a = *(const f32x4*)(x + o), b = *(const f32x4*)(x + o + 4);
              *(bf16x8*)(XB + o) = pack8(a, b);
              ss += (a[0] * a[0] + a[1] * a[1]) + (a[2] * a[2] + a[3] * a[3]) + (b[0] * b[0] + b[1] * b[1]) + (b[2] * b[2] + b[3] * b[3]); }
#pragma unroll
          for (int o = 32; o > 0; o >>= 1) ss += __shfl_xor(ss, o);
          if (lane == 0) *(f32x4*)(ssqx + (size_t)row * 4) = (f32x4){ss, 0.f, 0.f, 0.f};
      } }
    { float* rcm = (float*)(p.ws + WS_ROPEM); float* rsm = rcm + SEQ * 32; float* rcr = (float*)(p.ws + WS_ROPER); float* rsr = rcr + SEQ * 16;
      for (int i = wg * 512 + tid; i < SEQ * 48; i += G * 512) {
          const bool mla = i < SEQ * 32; const int j = mla ? i : i - SEQ * 32; const int half = mla ? 32 : 16; const int pos = j / half, f = j % half;
          const float inv = (float)exp2(-(double)f / (double)half * 13.287712379549449);
          const float ang = (float)pos * inv;
          const double rev = (double)ang * 0.15915494309189535; const float fr_ = (float)(rev - rint(rev));
          const float c = __builtin_amdgcn_cosf(fr_), s = __builtin_amdgcn_sinf(fr_);
          if (mla) { rcm[j] = c; rsm[j] = s; } else { rcr[j] = c; rsr[j] = s; }
      } }
}

constexpr int AT_KN = 0, AT_KR = 32768, AT_V = 49152, AT_WS = 81920, AT_LDS = 81920 + 8 * 256;
constexpr int SHM_V = 16384;
__device__ __forceinline__ int v_st(int k, int c) { const int kk = (k & ~0xC) | ((k & 4) << 1) | ((k & 8) >> 1); return ((kk >> 3) * 4 + (c >> 5)) * 512 + ((kk & 7) * 32 + (c & 31)) * 2; }
__device__ __forceinline__ int v_rd_base(int lane) { return ((lane & 3) << 3) | (((lane >> 2) & 3) << 6) | (((lane >> 4) & 1) << 5) | (((lane >> 5) & 1) << 8); }
#define KN_OFF(row, ch) ((row) * 256 + ((((ch) ^ ((row) & 15))) << 4))
#define KR_OFF(row, ch) ((row) * 128 + ((((ch) ^ (((row) >> 1) & 7))) << 4))
#define PK4(P, B_, OUT) do { unsigned a0 = cvtpk(P[B_+0], P[B_+1]), a1 = cvtpk(P[B_+2], P[B_+3]);                          \
        unsigned b0 = cvtpk(P[B_+4], P[B_+5]), b1 = cvtpk(P[B_+6], P[B_+7]);                                             \
        auto r0 = __builtin_amdgcn_permlane32_swap(a0, b0, false, false); auto r1 = __builtin_amdgcn_permlane32_swap(a1, b1, false, false); \
        u32x4 w = {r0[0], r1[0], r0[1], r1[1]}; OUT = *reinterpret_cast<bf16x8*>(&w); } while (0)
#define KRD128(dst, addr, off) asm volatile("ds_read_b128 %0, %1 offset:%2" : "=&v"(dst) : "v"(addr), "i"(off) : "memory")
#ifndef A16_RING
#define A16_RING 6
#endif
#define TRRD(dst, addr, off) asm volatile("ds_read_b64_tr_b16 %0, %1 offset:%2" : "=&v"(dst) : "v"(addr), "i"(off) : "memory")

__device__ __forceinline__ void attn_unit(lptr lds, const bf16_t* Q, const bf16_t* KV, const bf16_t* KRb, bf16_t* Y, const float* gain, int b, int h, int qb) {
    int tid = threadIdx.x; asm volatile("" : "+v"(tid));
    const int wid = __builtin_amdgcn_readfirstlane(tid >> 6), lane = tid & 63, r32 = lane & 31, hi = lane >> 5;
    const int P0 = qb * 256, tok0 = b * SEQ, NT = 4 * (qb + 1), w0 = P0 + wid * 32;
    volatile LAS float* wsc = (volatile LAS float*)(lds + AT_WS) + wid * 64;
    bf16x8 qf[12];
    { const bf16_t* qp = Q + (size_t)(tok0 + w0 + r32) * NQ + h * 192 + hi * 8;
#pragma unroll
      for (int d = 0; d < 12; ++d) qf[d] = *(const bf16x8*)(qp + d * 16); }
    const int sr = tid >> 4, scc = tid & 15, rr = tid >> 3, rch = tid & 7;
    const unsigned kvo = (unsigned)(((tok0 + sr) * NKV + h * 256 + scc * 8) * 2), kro = (unsigned)(((tok0 + rr) * 64 + rch * 8) * 2);
    const int kn_w = KN_OFF(sr, scc), kr_w = KR_OFF(rr, rch), v_w0 = v_st(sr, scc * 8), v_w1 = v_st(32 + sr, scc * 8);
    const int vb0 = (int)(unsigned)(size_t)(lds + AT_V) + v_rd_base(lane);
    bf16x8 sk0, sk1, sv0, sv1, skr;
#define AT_LOAD(t) do { const char* kb_ = (const char*)KV + (size_t)(t) * 64 * NKV * 2; const char* rb_ = (const char*)KRb + (size_t)(t) * 64 * 64 * 2; \
        sk0 = *(const bf16x8*)(kb_ + kvo); sk1 = *(const bf16x8*)(kb_ + 32 * NKV * 2 + kvo); \
        sv0 = *(const bf16x8*)(kb_ + 256 + kvo); sv1 = *(const bf16x8*)(kb_ + 32 * NKV * 2 + 256 + kvo); skr = *(const bf16x8*)(rb_ + kro); } while (0)
#define AT_WRITE(bf) do { *(LAS bf16x8*)(lds + AT_KN + (bf) * 16384 + kn_w) = sk0; *(LAS bf16x8*)(lds + AT_KN + (bf) * 16384 + kn_w + 32 * 256) = sk1; \
        *(LAS bf16x8*)(lds + AT_V + (bf) * SHM_V + v_w0) = sv0; *(LAS bf16x8*)(lds + AT_V + (bf) * SHM_V + v_w1) = sv1; *(LAS bf16x8*)(lds + AT_KR + (bf) * 8192 + kr_w) = skr; } while (0)
    float m_reg = -1e30f, l_reg = 0.f; f32x16 o[4];
#pragma unroll
    for (int d = 0; d < 4; ++d) o[d] = (f32x16){};
    AT_LOAD(0); AT_WRITE(0);
#pragma unroll
    for (int d = 0; d < 12; ++d) asm volatile("" : "+v"(qf[d]));
    __syncthreads();
    if (wid >= 4) __builtin_amdgcn_s_setprio(1);
    for (int t = 0; t < NT; ++t) {
        const int bf = t & 1, kb = t * 64;
        if (t + 1 < NT) AT_LOAD(t + 1);
        if (kb <= w0 + 31) {
            f32x16 p0 = (f32x16){}, p1 = (f32x16){};
            const lptr kn = lds + AT_KN + bf * 16384; const lptr kr = lds + AT_KR + bf * 8192;
            bf16x8 ka[2][4];
#define AT_KLOAD(g, bu) do { _Pragma("unroll") for (int dd = 0; dd < 2; ++dd) { const int d_ = 2 * (g) + dd; \
                if (d_ < 8) { ka[bu][2 * dd] = *(const LAS bf16x8*)(kn + KN_OFF(r32, 2 * d_ + hi)); ka[bu][2 * dd + 1] = *(const LAS bf16x8*)(kn + KN_OFF(r32, 2 * d_ + hi) + 32 * 256); } \
                else { ka[bu][2 * dd] = *(const LAS bf16x8*)(kr + KR_OFF(r32, 2 * (d_ - 8) + hi)); ka[bu][2 * dd + 1] = *(const LAS bf16x8*)(kr + KR_OFF(r32, 2 * (d_ - 8) + hi) + 32 * 128); } } } while (0)
#define AT_KMMA(g, bu) do { _Pragma("unroll") for (int dd = 0; dd < 2; ++dd) { \
                p0 = __builtin_amdgcn_mfma_f32_32x32x16_bf16(ka[bu][2 * dd], qf[2 * (g) + dd], p0, 0, 0, 0); p1 = __builtin_amdgcn_mfma_f32_32x32x16_bf16(ka[bu][2 * dd + 1], qf[2 * (g) + dd], p1, 0, 0, 0); } } while (0)
            AT_KLOAD(0, 0); __builtin_amdgcn_sched_barrier(0);
            AT_KLOAD(1, 1); __builtin_amdgcn_sched_barrier(0); AT_KMMA(0, 0); __builtin_amdgcn_sched_barrier(0);
            AT_KLOAD(2, 0); __builtin_amdgcn_sched_barrier(0); AT_KMMA(1, 1); __builtin_amdgcn_sched_barrier(0);
            AT_KLOAD(3, 1); __builtin_amdgcn_sched_barrier(0); AT_KMMA(2, 0); __builtin_amdgcn_sched_barrier(0);
            AT_KLOAD(4, 0); __builtin_amdgcn_sched_barrier(0); AT_KMMA(3, 1); __builtin_amdgcn_sched_barrier(0);
            AT_KLOAD(5, 1); __builtin_amdgcn_sched_barrier(0); AT_KMMA(4, 0); __builtin_amdgcn_sched_barrier(0);
            AT_KMMA(5, 1); __builtin_amdgcn_sched_barrier(0);
#undef AT_KLOAD
#undef AT_KMMA
            if (kb + 63 > w0) {
                const int dq = w0 + r32 - kb - 4 * hi;
                const float NEG = -__builtin_inff();
#pragma unroll
                for (int r = 0; r < 16; ++r) { const int c = (r & 3) + 8 * (r >> 2); if (c > dq) p0[r] = NEG; if (c + 32 > dq) p1[r] = NEG; }
            }
            float pmax = p0[0];
#pragma unroll
            for (int r = 1; r < 16; ++r) pmax = fmaxf(pmax, p0[r]);
#pragma unroll
            for (int r = 0; r < 16; ++r) pmax = fmaxf(pmax, p1[r]);
            { auto rr2 = __builtin_amdgcn_permlane32_swap(__float_as_uint(pmax), __float_as_uint(pmax), false, false); pmax = fmaxf(__uint_as_float(rr2[0]), __uint_as_float(rr2[1])); }
            if (!__all(pmax - m_reg <= 11.5f)) {
                const float mn = fmaxf(m_reg, pmax), alpha = __builtin_amdgcn_exp2f(m_reg - mn); m_reg = mn; l_reg *= alpha;
                if (hi == 0) wsc[r32] = alpha;
#pragma unroll
                for (int r = 0; r < 16; ++r) { const float al = wsc[crow(r, hi)];
#pragma unroll
                    for (int d = 0; d < 4; ++d) o[d][r] *= al; }
            }
            float ps = 0.f;
#pragma unroll
            for (int r = 0; r < 16; ++r) { p0[r] = __builtin_amdgcn_exp2f(p0[r] - m_reg); p1[r] = __builtin_amdgcn_exp2f(p1[r] - m_reg); ps += p0[r] + p1[r]; }
            { auto rr2 = __builtin_amdgcn_permlane32_swap(__float_as_uint(ps), __float_as_uint(ps), false, false); ps = __uint_as_float(rr2[0]) + __uint_as_float(rr2[1]); }
            l_reg += ps;
            bf16x8 pa0, pa1, pa2, pa3;
            PK4(p0, 0, pa0); PK4(p0, 8, pa1); PK4(p1, 0, pa2); PK4(p1, 8, pa3);
            const int vb = vb0 + bf * SHM_V;
            s16x4 vl[2][4], vh[2][4];
#define PV_RD(d0, se) do { constexpr int b_ = (d0) * 512; TRRD(vl[se][0], vb, b_); TRRD(vh[se][0], vb, b_ + 2048); TRRD(vl[se][1], vb, b_ + 4096); TRRD(vh[se][1], vb, b_ + 6144); \
            TRRD(vl[se][2], vb, b_ + 8192); TRRD(vh[se][2], vb, b_ + 10240); TRRD(vl[se][3], vb, b_ + 12288); TRRD(vh[se][3], vb, b_ + 14336); } while (0)
#define PV_MM(d0, se) do { \
            o[d0] = __builtin_amdgcn_mfma_f32_32x32x16_bf16(pa0, (bf16x8){vl[se][0][0], vl[se][0][1], vl[se][0][2], vl[se][0][3], vh[se][0][0], vh[se][0][1], vh[se][0][2], vh[se][0][3]}, o[d0], 0, 0, 0); \
            o[d0] = __builtin_amdgcn_mfma_f32_32x32x16_bf16(pa1, (bf16x8){vl[se][1][0], vl[se][1][1], vl[se][1][2], vl[se][1][3], vh[se][1][0], vh[se][1][1], vh[se][1][2], vh[se][1][3]}, o[d0], 0, 0, 0); \
            o[d0] = __builtin_amdgcn_mfma_f32_32x32x16_bf16(pa2, (bf16x8){vl[se][2][0], vl[se][2][1], vl[se][2][2], vl[se][2][3], vh[se][2][0], vh[se][2][1], vh[se][2][2], vh[se][2][3]}, o[d0], 0, 0, 0); \
            o[d0] = __builtin_amdgcn_mfma_f32_32x32x16_bf16(pa3, (bf16x8){vl[se][3][0], vl[se][3][1], vl[se][3][2], vl[se][3][3], vh[se][3][0], vh[se][3][1], vh[se][3][2], vh[se][3][3]}, o[d0], 0, 0, 0); } while (0)
            PV_RD(0, 0);
            PV_RD(1, 1); asm volatile("s_waitcnt lgkmcnt(8)" ::: "memory"); __builtin_amdgcn_sched_barrier(0); PV_MM(0, 0); __builtin_amdgcn_sched_barrier(0);
            PV_RD(2, 0); asm volatile("s_waitcnt lgkmcnt(8)" ::: "memory"); __builtin_amdgcn_sched_barrier(0); PV_MM(1, 1); __builtin_amdgcn_sched_barrier(0);
            PV_RD(3, 1); asm volatile("s_waitcnt lgkmcnt(8)" ::: "memory"); __builtin_amdgcn_sched_barrier(0); PV_MM(2, 0); __builtin_amdgcn_sched_barrier(0);
            asm volatile("s_waitcnt lgkmcnt(0)" ::: "memory"); __builtin_amdgcn_sched_barrier(0); PV_MM(3, 1);
#undef PV_RD
#undef PV_MM
#define PV_D0(x)
#undef PV_D0
        }
        if (t + 1 < NT) AT_WRITE(bf ^ 1);
        __syncthreads();
    }
#undef AT_LOAD
#undef AT_WRITE
    __builtin_amdgcn_s_setprio(0);
    if (hi == 0) wsc[r32] = l_reg;
    float rli[16];
#pragma unroll
    for (int r = 0; r < 16; ++r) rli[r] = __builtin_amdgcn_rcpf(wsc[crow(r, hi)]);
    (void)gain;
    bf16_t* yw = Y + (size_t)(tok0 + w0) * DM + h * 128;
#pragma unroll
    for (int r = 0; r < 16; ++r) {
        float v[4], ss = 0.f;
#pragma unroll
        for (int d = 0; d < 4; ++d) { v[d] = o[d][r] * rli[r]; ss += v[d] * v[d]; }
        ss += __shfl_xor(ss, 1); ss += __shfl_xor(ss, 2); ss += __shfl_xor(ss, 4); ss += __shfl_xor(ss, 8); ss += __shfl_xor(ss, 16);
        const float rstd = __builtin_amdgcn_rsqf(ss * (1.0f / 128.0f) + EPS);
        const int orow = crow(r, hi);
#pragma unroll
        for (int d = 0; d < 4; ++d) { const float y = v[d] * rstd; const float yn = __shfl_xor(y, 1);
            if ((r32 & 1) == 0) *(unsigned*)(yw + (size_t)orow * DM + d * 32 + r32) = cvtpk(y, yn); }
    }
    __syncthreads();
}

#define V16_OFF(row, c) ((row) * 256 + (((((c) >> 4) ^ ((row) & 7))) << 5) + (((c) >> 3) & 1) * 16)
__device__ __forceinline__ void attn_unit16(lptr lds, const bf16_t* Q, const bf16_t* KV, const bf16_t* KRb, bf16_t* Y, int b, int h, int qb, bool rev) {
    int tid = threadIdx.x; asm volatile("" : "+v"(tid));
    const int wid = __builtin_amdgcn_readfirstlane(tid >> 6), lane = tid & 63, c16 = lane & 15, fq = lane >> 4;
    const int P0 = qb * 256, tok0 = b * SEQ, NT = 4 * (qb + 1), w0 = P0 + wid * 32;
    volatile LAS float* wsc = (volatile LAS float*)(lds + AT_WS) + wid * 64;
    bf16x8 qf[2][6];
#pragma unroll
    for (int mb = 0; mb < 2; ++mb) { const bf16_t* qp = Q + (size_t)(tok0 + w0 + 16 * mb + c16) * NQ + h * 192 + 8 * fq;
#pragma unroll
        for (int s_ = 0; s_ < 6; ++s_) qf[mb][s_] = *(const bf16x8*)(qp + 32 * s_); }
    const int dl_ = tid & 63, rK = 4 * wid + (dl_ >> 4), pK = dl_ & 15, rR = 8 * wid + (dl_ >> 3), pR = dl_ & 7;
    const unsigned kn_src = (unsigned)(((tok0 + rK) * NKV + h * 256 + ((pK ^ (rK & 15)) << 3)) * 2);
    const unsigned v_src = (unsigned)(((tok0 + rK) * NKV + h * 256 + 128 + ((((pK >> 1) ^ (rK & 7)) << 4) + (pK & 1) * 8)) * 2);
    const unsigned kr_src = (unsigned)(((tok0 + rR) * 64 + ((pR ^ ((rR >> 1) & 7)) << 3)) * 2);
#define A16_GLDS(src, dst) __builtin_amdgcn_global_load_lds((const unsigned*)(src), (LAS unsigned*)(dst), 16, 0, 0)
#define A16_DMA(t, sl) do { const char* kb_ = (const char*)KV + (size_t)(t) * 64 * NKV * 2; const char* rb_ = (const char*)KRb + (size_t)(t) * 64 * 64 * 2; \
        A16_GLDS(kb_ + kn_src, lds + AT_KN + (sl) * 16384 + wid * 1024); A16_GLDS(kb_ + 32 * NKV * 2 + kn_src, lds + AT_KN + (sl) * 16384 + 8192 + wid * 1024); \
        A16_GLDS(rb_ + kr_src, lds + AT_KR + (sl) * 8192 + wid * 1024); \
        A16_GLDS(kb_ + v_src, lds + AT_V + (sl) * SHM_V + wid * 1024); A16_GLDS(kb_ + 32 * NKV * 2 + v_src, lds + AT_V + (sl) * SHM_V + 8192 + wid * 1024); } while (0)
    float m_ref[2] = {0.f, 0.f}, lsum[2] = {0.f, 0.f}; bool fresh = true;
    f32x4 o[2][8];
#pragma unroll
    for (int mb = 0; mb < 2; ++mb)
#pragma unroll
        for (int cb = 0; cb < 8; ++cb) o[mb][cb] = (f32x4){0.f, 0.f, 0.f, 0.f};
    A16_DMA(rev ? NT - 1 : 0, 0);
#pragma unroll
    for (int mb = 0; mb < 2; ++mb)
#pragma unroll
        for (int s_ = 0; s_ < 6; ++s_) asm volatile("" : "+v"(qf[mb][s_]));
    asm volatile("s_waitcnt vmcnt(0)" ::: "memory");
    __syncthreads();
    if (wid >= 4) __builtin_amdgcn_s_setprio(1);
    for (int t = 0; t < NT; ++t) {
        const int bf = t & 1, tt = rev ? NT - 1 - t : t, kb = tt * 64;
        if (t + 1 < NT) A16_DMA(rev ? tt - 1 : tt + 1, bf ^ 1);
        if (kb <= w0 + 31) {
            int la_ = lane; asm volatile("" : "+v"(la_));
            const int c16a = la_ & 15, fqa = la_ >> 4;
            const lptr kn = lds + AT_KN + bf * 16384 + c16a * 256, kr = lds + AT_KR + bf * 8192 + c16a * 128;
            f32x4 sc[2][4];
#pragma unroll
            for (int mb = 0; mb < 2; ++mb) { const float nm_ = -m_ref[mb];
#pragma unroll
                for (int k4 = 0; k4 < 4; ++k4) sc[mb][k4] = (f32x4){nm_, nm_, nm_, nm_}; }
            int ka[6];
            { const int knb = (int)(unsigned)(size_t)kn, krb = (int)(unsigned)(size_t)kr;
#pragma unroll
              for (int s_ = 0; s_ < 4; ++s_) ka[s_] = knb + (((4 * s_ + fqa) ^ c16a) << 4);
#pragma unroll
              for (int s_ = 0; s_ < 2; ++s_) ka[4 + s_] = krb + (((4 * s_ + fqa) ^ ((c16a >> 1) & 7)) << 4); }
#define A16_KRD(dst, it_) do { const int k4_ = (it_) / 6, s__ = (it_) % 6; if (s__ < 4) KRD128(dst, ka[s__ < 4 ? s__ : 0], k4_ * 4096); else KRD128(dst, ka[s__ < 4 ? 4 : s__], k4_ * 2048); } while (0)
#define A16_KWAIT(n_, r_) asm volatile("s_waitcnt lgkmcnt(" #n_ ")" : "+v"(r_) :: "memory")
            bf16x8 kf[A16_RING];
#pragma unroll
            for (int it = 0; it < A16_RING - 1; ++it) A16_KRD(kf[it], it);
#pragma unroll
            for (int it = 0; it < 24; ++it) {
                const int k4 = it / 6, s_ = it % 6, ahead = it + A16_RING - 1 < 24 ? A16_RING - 1 : 23 - it;
                if (it + A16_RING - 1 < 24) A16_KRD(kf[(it + A16_RING - 1) % A16_RING], it + A16_RING - 1);
                if (ahead == 5) A16_KWAIT(5, kf[it % A16_RING]); else if (ahead == 4) A16_KWAIT(4, kf[it % A16_RING]); else if (ahead == 3) A16_KWAIT(3, kf[it % A16_RING]); else if (ahead == 2) A16_KWAIT(2, kf[it % A16_RING]); else if (ahead == 1) A16_KWAIT(1, kf[it % A16_RING]); else A16_KWAIT(0, kf[it % A16_RING]);
                sc[0][k4] = __builtin_amdgcn_mfma_f32_16x16x32_bf16(kf[it % A16_RING], qf[0][s_], sc[0][k4], 0, 0, 0);
                sc[1][k4] = __builtin_amdgcn_mfma_f32_16x16x32_bf16(kf[it % A16_RING], qf[1][s_], sc[1][k4], 0, 0, 0);
            }
#undef A16_KRD
#undef A16_KWAIT
            if (kb + 63 > w0) {
                const float NEG = -__builtin_inff();
#pragma unroll
                for (int mb = 0; mb < 2; ++mb) { const int dq = w0 + 16 * mb + c16 - kb - 4 * fq;
#pragma unroll
                    for (int k4 = 0; k4 < 4; ++k4)
#pragma unroll
                        for (int i = 0; i < 4; ++i) if (16 * k4 + i > dq) sc[mb][k4][i] = NEG; }
            }
            float lmax[2];
#pragma unroll
            for (int mb = 0; mb < 2; ++mb) { lmax[mb] = sc[mb][0][0];
#pragma unroll
                for (int k4 = 0; k4 < 4; ++k4)
#pragma unroll
                    for (int i = 0; i < 4; ++i) lmax[mb] = fmaxf(lmax[mb], sc[mb][k4][i]); }
            if (fresh || !__all((lmax[0] <= 11.5f) && (lmax[1] <= 11.5f))) {
#pragma unroll
                for (int mb = 0; mb < 2; ++mb) {
                    float rm = lmax[mb]; rm = fmaxf(rm, __shfl_xor(rm, 16)); rm = fmaxf(rm, __shfl_xor(rm, 32));
                    const float dl = fresh ? rm : fmaxf(rm, 0.f), alpha = fresh ? 1.0f : __builtin_amdgcn_exp2f(-dl); m_ref[mb] += dl; lsum[mb] *= alpha;
                    if (fq == 0) wsc[mb * 16 + c16] = alpha;
#pragma unroll
                    for (int k4 = 0; k4 < 4; ++k4)
#pragma unroll
                        for (int i = 0; i < 4; ++i) sc[mb][k4][i] -= dl;
                }
#pragma unroll
                for (int mb = 0; mb < 2; ++mb)
#pragma unroll
                    for (int i = 0; i < 4; ++i) { const float al = wsc[mb * 16 + 4 * fq + i];
#pragma unroll
                        for (int cb = 0; cb < 8; ++cb) o[mb][cb][i] *= al; }
            }
            bf16x8 pf[2][2];
#pragma unroll
            for (int mb = 0; mb < 2; ++mb) {
                float ps = 0.f;
#pragma unroll
                for (int k4 = 0; k4 < 4; ++k4)
#pragma unroll
                    for (int i = 0; i < 4; ++i) { sc[mb][k4][i] = __builtin_amdgcn_exp2f(sc[mb][k4][i]); ps += sc[mb][k4][i]; }
                lsum[mb] += ps;
#pragma unroll
                for (int g = 0; g < 2; ++g) { u32x4 w = {cvtpk(sc[mb][2 * g][0], sc[mb][2 * g][1]), cvtpk(sc[mb][2 * g][2], sc[mb][2 * g][3]), cvtpk(sc[mb][2 * g + 1][0], sc[mb][2 * g + 1][1]), cvtpk(sc[mb][2 * g + 1][2], sc[mb][2 * g + 1][3])};
                    pf[mb][g] = *reinterpret_cast<bf16x8*>(&w); }
            }
            const int tq_ = c16a >> 2, tp_ = c16a & 3, vrow_ = 4 * fqa + tq_;
            const int vbase = (int)(unsigned)(size_t)(lds + AT_V + bf * SHM_V) + vrow_ * 256 + 8 * tp_;
            const int vx = (vrow_ & 7) << 5;
            s16x4 va[2][2];
#define A16_VRD(g, cb, se) do { const int a_ = vbase + (vx ^ ((cb) << 5)); TRRD(va[se][0], a_, (g) * 8192); TRRD(va[se][1], a_, (g) * 8192 + 4096); } while (0)
#define A16_VWAIT(n_, se) asm volatile("s_waitcnt lgkmcnt(" #n_ ")" : "+v"(va[se][0]), "+v"(va[se][1]) :: "memory")
#define A16_VMM(g, cb, se) do { const bf16x8 vf_ = (bf16x8){va[se][0][0], va[se][0][1], va[se][0][2], va[se][0][3], va[se][1][0], va[se][1][1], va[se][1][2], va[se][1][3]}; \
                o[0][cb] = __builtin_amdgcn_mfma_f32_16x16x32_bf16(pf[0][g], vf_, o[0][cb], 0, 0, 0); o[1][cb] = __builtin_amdgcn_mfma_f32_16x16x32_bf16(pf[1][g], vf_, o[1][cb], 0, 0, 0); } while (0)
            A16_VRD(0, 0, 0);
#pragma unroll
            for (int it = 0; it < 16; ++it) {
                const int g = it >> 3, cb = it & 7;
                if (it + 1 < 16) { if ((it & 1) == 0) A16_VRD((it + 1) >> 3, (it + 1) & 7, 1); else A16_VRD((it + 1) >> 3, (it + 1) & 7, 0); }
                if (it + 1 < 16) { if ((it & 1) == 0) A16_VWAIT(2, 0); else A16_VWAIT(2, 1); } else { A16_VWAIT(0, 1); }
                if ((it & 1) == 0) A16_VMM(g, cb, 0); else A16_VMM(g, cb, 1);
            }
#undef A16_VRD
#undef A16_VWAIT
#undef A16_VMM
            fresh = false;
        }
        asm volatile("s_waitcnt vmcnt(0)" ::: "memory");
        __syncthreads();
    }
#undef A16_DMA
#undef A16_GLDS
    __builtin_amdgcn_s_setprio(0);
#pragma unroll
    for (int mb = 0; mb < 2; ++mb) { float l = lsum[mb]; l += __shfl_xor(l, 16); l += __shfl_xor(l, 32); if (fq == 0) wsc[mb * 16 + c16] = l; }
    bf16_t* yw = Y + (size_t)(tok0 + w0) * DM + h * 128 + c16;
#pragma unroll
    for (int mb = 0; mb < 2; ++mb)
#pragma unroll
        for (int i = 0; i < 4; ++i) {
            const float rl = __builtin_amdgcn_rcpf(wsc[mb * 16 + 4 * fq + i]);
            float v[8], ss = 0.f;
#pragma unroll
            for (int cb = 0; cb < 8; ++cb) { v[cb] = o[mb][cb][i] * rl; ss += v[cb] * v[cb]; }
            ss += __shfl_xor(ss, 1); ss += __shfl_xor(ss, 2); ss += __shfl_xor(ss, 4); ss += __shfl_xor(ss, 8);
            const float rstd = __builtin_amdgcn_rsqf(ss * (1.0f / 128.0f) + EPS);
            bf16_t* yr = yw + (size_t)(16 * mb + 4 * fq + i) * DM;
#pragma unroll
            for (int cb = 0; cb < 8; ++cb) { const float y = v[cb] * rstd; const float yn = __shfl_xor(y, 1);
                if ((c16 & 1) == 0) *(unsigned*)(yr + 16 * cb) = cvtpk(y, yn); }
        }
    __syncthreads();
}

constexpr int LW = 18688;
__device__ __forceinline__ float logsig(float x) { return fminf(x, 0.f) - __logf(1.0f + __expf(-fabsf(x))); }

template <bool GLA>
__device__ __forceinline__ void lin_stage(lptr wl, const bf16_t* Z, int tok, int h, int lane, bool need_q) {
    constexpr int QO = GLA ? ZC_GQ : ZC_RQ, KO = GLA ? ZC_GK : ZC_RK, VO = GLA ? ZC_GV : ZC_RV;
#pragma unroll
    for (int i = 0; i < 8; ++i) { const int idx = i * 64 + lane, row = idx >> 3, ch = idx & 7;
        *(LAS bf16x8*)(wl + 8192 + row * 128 + ch * 16) = *(const bf16x8*)(Z + (size_t)(tok + row) * NZ + VO + h * 64 + ch * 8); }
#pragma unroll
    for (int i = 0; i < 4; ++i) { const int idx = i * 64 + lane, row = idx >> 2, ch = idx & 3;
        *(LAS bf16x8*)(wl + 4096 + row * 64 + ch * 16) = *(const bf16x8*)(Z + (size_t)(tok + row) * NZ + KO + h * 32 + ch * 8);
        if (need_q) *(LAS bf16x8*)(wl + row * 64 + ch * 16) = *(const bf16x8*)(Z + (size_t)(tok + row) * NZ + QO + h * 32 + ch * 8); }
    if (GLA) {
#pragma unroll
        for (int i = 0; i < 2; ++i) { const int idx = i * 64 + lane, row = idx >> 1, ch = idx & 1;
            *(LAS bf16x8*)(wl + 16384 + row * 32 + ch * 16) = *(const bf16x8*)(Z + (size_t)(tok + row) * NZ + ZC_GLR + ch * 8); }
    }
}
template <bool GLA>
__device__ __forceinline__ void lin_decay(lptr wl, int lane, int pos0, bf16x8 wgf, float bgk, float log_g, const float* rcr, const float* rsr, bool need_q) {
    const int kk = lane & 31, hi = lane >> 5;
    f32x16 bb[2];
    if (GLA) {
#pragma unroll
        for (int blk = 0; blk < 2; ++blk) {
            const bf16x8 af = *(const LAS bf16x8*)(wl + 16384 + (32 * blk + kk) * 32 + hi * 16);
            bb[blk] = __builtin_amdgcn_mfma_f32_32x32x16_bf16(af, wgf, (f32x16){}, 0, 0, 0);
        }
        float T[8], Tp[8];
#pragma unroll
        for (int blk = 0; blk < 2; ++blk)
#pragma unroll
            for (int g = 0; g < 4; ++g) {
                float run = 0.f;
#pragma unroll
                for (int i = 0; i < 4; ++i) { run += logsig(bb[blk][4 * g + i] + bgk) * (1.0f / 16.0f); bb[blk][4 * g + i] = run; }
                T[blk * 4 + g] = run;
            }
#pragma unroll
        for (int s = 0; s < 8; ++s) Tp[s] = __shfl_xor(T[s], 32);
        float off = 0.f;
#pragma unroll
        for (int s = 0; s < 8; ++s) {
            const float o = off + (hi ? Tp[s] : 0.f);
#pragma unroll
            for (int i = 0; i < 4; ++i) bb[s >> 2][4 * (s & 3) + i] += o;
            off += T[s] + Tp[s];
        }
        if (hi == 0) *(LAS float*)(wl + 18432 + kk * 4) = __expf(off);
    } else {
        float lg = log_g; asm volatile("" : "+v"(lg));
#pragma unroll
        for (int blk = 0; blk < 2; ++blk)
#pragma unroll
            for (int r = 0; r < 16; ++r) bb[blk][r] = (float)(32 * blk + crow(r, hi) + 1) * lg;
        if (hi == 0) *(LAS float*)(wl + 18432 + kk * 4) = __expf(64.0f * lg);
    }
    constexpr float SC = 0.17677669529663687f;
    lptr ob = wl + ((4 * hi) * 32 + kk) * 2; lptr pb = wl + ((4 * hi) * 32 + (kk ^ 16)) * 2;
    asm volatile("" : "+v"(ob), "+v"(pb));
    const float* rc = rcr + (pos0 + 4 * hi) * 16 + (kk & 15); const float* rs = rsr + (pos0 + 4 * hi) * 16 + (kk & 15);
    float rcv[2][16], rsv[2][16];
    if (!GLA) {
#pragma unroll
        for (int blk = 0; blk < 2; ++blk)
#pragma unroll
            for (int r = 0; r < 16; ++r) { const int j0 = 32 * blk + (r & 3) + 8 * (r >> 2); rcv[blk][r] = rc[j0 * 16]; rsv[blk][r] = rs[j0 * 16]; }
    }
#pragma unroll
    for (int blk = 0; blk < 2; ++blk)
#pragma unroll
        for (int r = 0; r < 16; ++r) {
            const int j0 = 32 * blk + (r & 3) + 8 * (r >> 2);
            const float bj = bb[blk][r];
            float kv = bf2f(*(const LAS bf16_t*)(ob + 4096 + j0 * 64)), qv = need_q ? bf2f(*(const LAS bf16_t*)(ob + j0 * 64)) : 0.f;
            if (!GLA) {
                const float kp = bf2f(*(const LAS bf16_t*)(pb + 4096 + j0 * 64)), qp = need_q ? bf2f(*(const LAS bf16_t*)(pb + j0 * 64)) : 0.f;
                const float c = rcv[blk][r], sn = rsv[blk][r];
                kv = (kk < 16) ? kv * c - kp * sn : kv * c + kp * sn;
                qv = (kk < 16) ? qv * c - qp * sn : qv * c + qp * sn;
            }
            const float eb = __expf(bj), ei = __expf(-bj);
            *(LAS bf16_t*)(ob + 4096 + j0 * 64) = f2bf(kv * ei * (GLA ? 1.0f : SC));
            if (need_q) *(LAS bf16_t*)(ob + j0 * 64) = f2bf(qv * eb * (GLA ? SC : 1.0f));
            if ((r & 3) == 3) __builtin_amdgcn_sched_barrier(0);
        }
}

template <bool GLA>
__device__ __forceinline__ void lin_unit(lptr lds, const Params& p, int layer, int bh, int seg, int level, int unit) {
    int tid = threadIdx.x; asm volatile("" : "+v"(tid));
    const int wid = __builtin_amdgcn_readfirstlane(tid >> 6), lane = tid & 63, r32 = lane & 31, hi = lane >> 5;
    const int b = bh >> 2, h = bh & 3, tok0 = b * SEQ + seg * 1024;
    const bf16_t* Z = (const bf16_t*)(p.ws + WS_Z);
    lptr wl = lds + wid * LW;
    unsigned char* scr = (unsigned char*)p.out + (size_t)unit * LIN_SCR;
    float* Uc = (float*)scr; bf16_t* STc = (bf16_t*)(scr + 16 * 2048 * 4); float* Ec = (float*)(scr + 16 * 2048 * 4 + 16 * 2048 * 2);
    float* SUM = (float*)(p.ws + (GLA ? WS_SUMG : WS_SUMR));
    const float* rcr = (const float*)(p.ws + WS_ROPER); const float* rsr = rcr + SEQ * 16;
    bf16x8 wgf = (bf16x8){0, 0, 0, 0, 0, 0, 0, 0}; float bgk = 0.f;
    if (GLA) {
        const float* wg = p.in[8] + (size_t)layer * 16 * 128 + h * 32 + r32; bgk = p.in[9][layer * 128 + h * 32 + r32];
        f32x4 w0, w1;
#pragma unroll
        for (int i = 0; i < 4; ++i) { w0[i] = wg[(8 * hi + i) * 128]; w1[i] = wg[(8 * hi + 4 + i) * 128]; }
        wgf = pack8(w0, w1);
    }
    const float LG[4] = {-0.031748698314580298f, -0.015748356968139112f, -0.007843177461025893f, -0.003913899321136329f};
    const float log_g = h == 0 ? LG[0] : (h == 1 ? LG[1] : (h == 2 ? LG[2] : LG[3]));
    const int tg = lane >> 4, ti = lane & 15, tq = ti >> 2, tpq = ti & 3;
    const int ki_tr = (int)(unsigned)(size_t)(wl + 4096) + (8 * (tg >> 1) + tq) * 64 + (16 * (tg & 1) + 4 * tpq) * 2;
    const int vv_tr = (int)(unsigned)(size_t)(wl + 8192) + (8 * (tg >> 1) + tq) * 128 + (16 * (tg & 1) + 4 * tpq) * 2;
#pragma nounroll
    for (int ci_ = 0; ci_ < (level == 1 ? 2 + 2 * (LPROBE & 1) : 0); ++ci_) { const int ci = ci_ & 1;
        const int c = wid + 8 * ci;
        lin_stage<GLA>(wl, Z, tok0 + 64 * c, h, lane, false);
        lin_decay<GLA>(wl, lane, seg * 1024 + 64 * c, wgf, bgk, log_g, rcr, rsr, false);
        f32x16 u0 = (f32x16){}, u1 = (f32x16){};
#pragma unroll
        for (int s = 0; s < 4; ++s) {
            s16x4 al, ah, b0l, b0h, b1l, b1h;
            const int ka = ki_tr + s * 16 * 64, va = vv_tr + s * 16 * 128;
            TRRD(al, ka, 0); TRRD(ah, ka, 256); TRRD(b0l, va, 0); TRRD(b0h, va, 512); TRRD(b1l, va, 64); TRRD(b1h, va, 576);
            asm volatile("s_waitcnt lgkmcnt(0)" ::: "memory"); __builtin_amdgcn_sched_barrier(0);
            const bf16x8 af = (bf16x8){al[0], al[1], al[2], al[3], ah[0], ah[1], ah[2], ah[3]};
            u0 = __builtin_amdgcn_mfma_f32_32x32x16_bf16(af, (bf16x8){b0l[0], b0l[1], b0l[2], b0l[3], b0h[0], b0h[1], b0h[2], b0h[3]}, u0, 0, 0, 0);
            u1 = __builtin_amdgcn_mfma_f32_32x32x16_bf16(af, (bf16x8){b1l[0], b1l[1], b1l[2], b1l[3], b1h[0], b1h[1], b1h[2], b1h[3]}, u1, 0, 0, 0);
        }
        const LAS float* EB = (const LAS float*)(wl + 18432);
#pragma unroll
        for (int r = 0; r < 16; ++r) { const int kk = crow(r, hi); const float e = EB[kk];
            Uc[c * 2048 + kk * 64 + r32] = u0[r] * e; Uc[c * 2048 + kk * 64 + 32 + r32] = u1[r] * e; }
        if (lane < 32) Ec[c * 32 + lane] = EB[lane];
    }
    asm volatile("s_waitcnt vmcnt(0)" ::: "memory");
    __syncthreads();
    {
        const int vv = tid & 63, kk0 = (tid >> 6) * 4;
        float S[4] = {0.f, 0.f, 0.f, 0.f};
        if (level == 2) {
            float su_u[7][4], su_d[7][4];
#pragma unroll
            for (int sp = 0; sp < 7; ++sp) { const float* su = SUM + (size_t)(bh * 8 + (sp < seg ? sp : 0)) * SUM_STRIDE;
#pragma unroll
                for (int i = 0; i < 4; ++i) { su_u[sp][i] = su[(kk0 + i) * 64 + vv]; su_d[sp][i] = su[2048 + kk0 + i]; } }
#pragma unroll
            for (int sp = 0; sp < 7; ++sp) if (sp < seg) {
#pragma unroll
                for (int i = 0; i < 4; ++i) S[i] = su_d[sp][i] * S[i] + su_u[sp][i]; }
        }
        __builtin_amdgcn_sched_barrier(0);
        float dtot[4] = {1.f, 1.f, 1.f, 1.f};
#pragma unroll
        for (int hh = 0; hh < 2; ++hh) {
            float uu[8][4], ee[8][4];
#pragma unroll
            for (int c8 = 0; c8 < 8; ++c8)
#pragma unroll
                for (int i = 0; i < 4; ++i) { uu[c8][i] = Uc[(hh * 8 + c8) * 2048 + (kk0 + i) * 64 + vv]; ee[c8][i] = Ec[(hh * 8 + c8) * 32 + kk0 + i]; }
#pragma unroll
            for (int c8 = 0; c8 < 8; ++c8) {
                if (level == 2) *(u32x2*)(STc + (hh * 8 + c8) * 2048 + vv * 32 + kk0) = (u32x2){cvtpk(S[0], S[1]), cvtpk(S[2], S[3])};
#pragma unroll
                for (int i = 0; i < 4; ++i) { S[i] = ee[c8][i] * S[i] + uu[c8][i]; dtot[i] *= ee[c8][i]; }
            }
            __builtin_amdgcn_sched_barrier(0);
        }
        if (level == 1) { float* su = SUM + (size_t)(bh * 8 + seg) * SUM_STRIDE;
#pragma unroll
            for (int i = 0; i < 4; ++i) { su[(kk0 + i) * 64 + vv] = S[i]; if (vv == 0) su[2048 + kk0 + i] = dtot[i]; } }
    }
    asm volatile("s_waitcnt vmcnt(0)" ::: "memory");
    __syncthreads();
    if (level == 1) return;
    constexpr int GO = GLA ? ZC_GG : ZC_RG, YO = GLA ? 512 : 768;
    bf16_t* Y = (bf16_t*)(p.ws + WS_YCAT);
#pragma nounroll
    for (int ci_ = 0; ci_ < 2 + 2 * ((LPROBE >> 1) & 1); ++ci_) { const int ci = ci_ & 1;
        const int c = wid + 8 * ci, tok = tok0 + 64 * c;
        bf16x8 sfr[2][2];
#pragma unroll
        for (int s2 = 0; s2 < 2; ++s2) { sfr[s2][0] = *(const bf16x8*)(STc + c * 2048 + r32 * 32 + 16 * s2 + 8 * hi); sfr[s2][1] = *(const bf16x8*)(STc + c * 2048 + (32 + r32) * 32 + 16 * s2 + 8 * hi); }
        for (int sd_ = 0; sd_ < 1 + ((LPROBE >> 2) & 1); ++sd_) {
        lin_stage<GLA>(wl, Z, tok, h, lane, true);
        lin_decay<GLA>(wl, lane, seg * 1024 + 64 * c, wgf, bgk, log_g, rcr, rsr, true); }
        __builtin_amdgcn_sched_barrier(0);
        const bf16_t* gpb = Z + (size_t)(tok + r32) * NZ + GO + h * 64 + 4 * hi;
        u32x2 gt[2][8];
#pragma unroll
        for (int ib = 0; ib < 2; ++ib)
#pragma unroll
            for (int q8 = 0; q8 < 8; ++q8) gt[ib][q8] = *(const u32x2*)(gpb + (size_t)(32 * ib) * NZ + 32 * (q8 >> 2) + 8 * (q8 & 3));
        f32x16 pt00 = (f32x16){}, pt01 = (f32x16){}, pt11 = (f32x16){};
#pragma unroll
        for (int s2 = 0; s2 < 2; ++s2) {
            const bf16x8 k0f = *(const LAS bf16x8*)(wl + 4096 + r32 * 64 + (16 * s2 + 8 * hi) * 2), k1f = *(const LAS bf16x8*)(wl + 4096 + (32 + r32) * 64 + (16 * s2 + 8 * hi) * 2);
            const bf16x8 q0f = *(const LAS bf16x8*)(wl + r32 * 64 + (16 * s2 + 8 * hi) * 2), q1f = *(const LAS bf16x8*)(wl + (32 + r32) * 64 + (16 * s2 + 8 * hi) * 2);
            pt00 = __builtin_amdgcn_mfma_f32_32x32x16_bf16(k0f, q0f, pt00, 0, 0, 0);
            pt01 = __builtin_amdgcn_mfma_f32_32x32x16_bf16(k0f, q1f, pt01, 0, 0, 0);
            pt11 = __builtin_amdgcn_mfma_f32_32x32x16_bf16(k1f, q1f, pt11, 0, 0, 0);
        }
#pragma unroll
        for (int r = 0; r < 16; ++r) if (crow(r, hi) > r32) { pt00[r] = 0.f; pt11[r] = 0.f; }
        bf16x8 pa[2][4];
        PK4(pt00, 0, pa[0][0]); PK4(pt00, 8, pa[0][1]);
        PK4(pt01, 0, pa[1][0]); PK4(pt01, 8, pa[1][1]); PK4(pt11, 0, pa[1][2]); PK4(pt11, 8, pa[1][3]);
        f32x16 oT[2][2];
#pragma unroll
        for (int vb = 0; vb < 2; ++vb)
#pragma unroll
            for (int ib = 0; ib < 2; ++ib) oT[vb][ib] = (f32x16){};
#pragma unroll
        for (int ks = 0; ks < 4; ++ks) {
            s16x4 b0l, b0h, b1l, b1h; const int va = vv_tr + ks * 16 * 128;
            TRRD(b0l, va, 0); TRRD(b0h, va, 512); TRRD(b1l, va, 64); TRRD(b1h, va, 576);
            asm volatile("s_waitcnt lgkmcnt(0)" ::: "memory"); __builtin_amdgcn_sched_barrier(0);
            const bf16x8 vb0 = (bf16x8){b0l[0], b0l[1], b0l[2], b0l[3], b0h[0], b0h[1], b0h[2], b0h[3]}, vb1 = (bf16x8){b1l[0], b1l[1], b1l[2], b1l[3], b1h[0], b1h[1], b1h[2], b1h[3]};
            if (ks < 2) { oT[0][0] = __builtin_amdgcn_mfma_f32_32x32x16_bf16(vb0, pa[0][ks], oT[0][0], 0, 0, 0); oT[1][0] = __builtin_amdgcn_mfma_f32_32x32x16_bf16(vb1, pa[0][ks], oT[1][0], 0, 0, 0); }
            oT[0][1] = __builtin_amdgcn_mfma_f32_32x32x16_bf16(vb0, pa[1][ks], oT[0][1], 0, 0, 0); oT[1][1] = __builtin_amdgcn_mfma_f32_32x32x16_bf16(vb1, pa[1][ks], oT[1][1], 0, 0, 0);
        }
#pragma unroll
        for (int s2 = 0; s2 < 2; ++s2) {
            const bf16x8 q0f = *(const LAS bf16x8*)(wl + r32 * 64 + (16 * s2 + 8 * hi) * 2), q1f = *(const LAS bf16x8*)(wl + (32 + r32) * 64 + (16 * s2 + 8 * hi) * 2);
            const bf16x8 s0f = sfr[s2][0], s1f = sfr[s2][1];
            oT[0][0] = __builtin_amdgcn_mfma_f32_32x32x16_bf16(s0f, q0f, oT[0][0], 0, 0, 0); oT[1][0] = __builtin_amdgcn_mfma_f32_32x32x16_bf16(s1f, q0f, oT[1][0], 0, 0, 0);
            oT[0][1] = __builtin_amdgcn_mfma_f32_32x32x16_bf16(s0f, q1f, oT[0][1], 0, 0, 0); oT[1][1] = __builtin_amdgcn_mfma_f32_32x32x16_bf16(s1f, q1f, oT[1][1], 0, 0, 0);
        }
        unsigned yo_ = (unsigned)((tok + r32) * DM + YO + h * 64 + 4 * hi); asm volatile("" : "+v"(yo_));
        bf16_t* ypb = Y + yo_;
#pragma unroll
        for (int ib = 0; ib < 2; ++ib) {
            float ss = 0.f;
#pragma unroll
            for (int vb = 0; vb < 2; ++vb)
#pragma unroll
                for (int r = 0; r < 16; ++r) ss += oT[vb][ib][r] * oT[vb][ib][r];
            { auto sw = __builtin_amdgcn_permlane32_swap(__float_as_uint(ss), __float_as_uint(ss), false, false); ss = __uint_as_float(sw[0]) + __uint_as_float(sw[1]); }
            const float rstd = __builtin_amdgcn_rsqf(ss * (1.0f / 64.0f) + EPS);
#pragma unroll
            for (int vb = 0; vb < 2; ++vb)
#pragma unroll
                for (int g4 = 0; g4 < 4; ++g4) {
                    const u32x2 gw = gt[ib][vb * 4 + g4];
                    const float y0 = oT[vb][ib][4 * g4 + 0] * rstd * silu_f(bflo(gw[0])), y1 = oT[vb][ib][4 * g4 + 1] * rstd * silu_f(bfhi(gw[0]));
                    const float y2 = oT[vb][ib][4 * g4 + 2] * rstd * silu_f(bflo(gw[1])), y3 = oT[vb][ib][4 * g4 + 3] * rstd * silu_f(bfhi(gw[1]));
                    *(u32x2*)(ypb + (size_t)(32 * ib) * DM + 32 * vb + 8 * g4) = (u32x2){cvtpk(y0, y1), cvtpk(y2, y3)};
                }
        }
    }
    __syncthreads();
}

constexpr int LDS_RING = 0, LDS_X = 131072, LDS_RS = LDS_X + 12288, LDS_MISC = LDS_RS + 12288, LDS_BYTES = LDS_MISC + 256;
static_assert(8 * LW <= LDS_MISC && AT_LDS <= LDS_MISC && LDS_RS + 12288 <= LDS_MISC, "phase scratch must not reach the barrier words");
constexpr int NPH = 2 + 6 * DEPTH;

__global__ void __launch_bounds__(512, 2) mk_fwd(Params p) {
    extern __shared__ __attribute__((aligned(16))) unsigned char lds[];
    LAS unsigned char* ldsl = (LAS unsigned char*)lds;
    const int tid = threadIdx.x, G = gridDim.x, wg = blockIdx.x;
    volatile LAS unsigned* misc = (volatile LAS unsigned*)(ldsl + LDS_MISC);
    if (tid < 4) misc[tid] = 0u;
    __syncthreads();
    unsigned* barw = (unsigned*)(p.ws + WS_BAR);
    XcdBarrier bar; bar.bar = barw; bar.x = 0; bar.st = misc;
    if (ONE_LAUNCH) bar = xcd_barrier_post(barw, misc);
#define WSP() size_t wso_ = 0; asm volatile("" : "+s"(wso_)); unsigned char* ws = p.ws + wso_; \
    bf16_t* XB = (bf16_t*)(ws + WS_XB); bf16_t* YC = (bf16_t*)(ws + WS_YCAT); bf16_t* KRb = (bf16_t*)(ws + WS_KR); bf16_t* Zb = (bf16_t*)(ws + WS_Z); \
    bf16_t* Qb = (bf16_t*)(ws + WS_Q); bf16_t* KVb = (bf16_t*)(ws + WS_KV); bf16_t* Gb = (bf16_t*)(ws + WS_G); \
    float* ssqx = (float*)(ws + WS_SSQX); float* ssqq = (float*)(ws + WS_SSQQ); float* ssqkv = (float*)(ws + WS_SSQKV); \
    const float* rcm = (const float*)(ws + WS_ROPEM); const float* rsm = rcm + SEQ * 32; \
    float* halo = (float*)(ws + WS_HALO); float* heada = (float*)(ws + WS_HEADA); float* headb = (float*)(ws + WS_HEADB); \
    const unsigned char* wl_ = ws + WS_W + (size_t)l * W_LAYER; \
    (void)XB; (void)YC; (void)KRb; (void)Zb; (void)Qb; (void)KVb; (void)Gb; (void)ssqx; (void)ssqq; (void)ssqkv; (void)rcm; (void)rsm; (void)halo; (void)heada; (void)headb; (void)wl_
#define RUN(k) (p.ph_lo <= (k) && (k) < p.ph_hi)
#define SEAM(k) do { if (RUN(k) && RUN((k) + 1)) xcd_barrier(bar); } while (0)
    REP(0) if (EN(0) && RUN(0)) prologue(p, (lptr)lds);
    SEAM(0);
    for (int l = 0; l < DEPTH; ++l) {
        const int pb = 1 + 6 * l;
        if (EN(1) && RUN(pb + 0)) { WSP();
            pg8::Gemm g{XB, (const bf16_t*)(wl_ + W_IN), DM, DM, DM}; pg8::StaticOrder S; S.init(MTOK / 256, NZ / 256 - 1, G, wg);
            REP(1) { pg8::EpiZ E{Zb, KRb, ssqx, ssqq, ssqkv, rcm, rsm, ldsl + LDS_X, (REP_NOEPI && ((REP_MASK >> 1) & 1) && rep_ == 0) ? 1 : 0};
            pg8::gemm_phase(ldsl + LDS_RING, g, S, E, (LAS float*)(ldsl + LDS_RS)); }
        }
        SEAM(pb + 0);
        if (RUN(pb + 1)) { WSP();
            REP(2) if (EN(2) && EN(11)) { pg8::Gemm g{Zb + ZC_CQ, (const bf16_t*)(wl_ + W_UQ), NZ, 384, 384}; pg8::StaticOrder S; S.init(MTOK / 256, NQ / 256, G, wg);
              pg8::EpiQ E{Qb, ssqq, rcm, rsm}; pg8::gemm_phase(ldsl + LDS_RING, g, S, E, (LAS float*)(ldsl + LDS_RS)); }
            REP(2) if (EN(2) && EN(12)) { pg8::Gemm g{XB, (const bf16_t*)(wl_ + W_IN), DM, DM, DM}; pg8::StaticOrder S; S.init(MTOK / 256, 1, G, G == 256 ? (wg >= 128 ? wg - 128 : 128) : wg); S.pn0 = NZ / 256 - 1;
              pg8::EpiZ E{Zb, KRb, ssqx, ssqq, ssqkv, rcm, rsm, ldsl + LDS_X, 0}; pg8::gemm_phase(ldsl + LDS_RING, g, S, E, (LAS float*)(ldsl + LDS_RS)); }
            REP(2) if (EN(2) && EN(12)) { pg8::Gemm g{Zb + ZC_CKV, (const bf16_t*)(wl_ + W_UKV), NZ, 256, 256}; pg8::StaticOrder S;
              if (G == 256) { S.init(MTOK / 256, NKV / 256, 128, wg < 128 ? wg : wg + 256); S.imax = wg < 128 ? 3 : 1; } else S.init(MTOK / 256, NKV / 256, G, (wg + 128) % G);
              pg8::EpiKV E{KVb, ssqkv}; pg8::gemm_phase(ldsl + LDS_RING, g, S, E, (LAS float*)(ldsl + LDS_RS)); }
            REP(3) if (EN(3)) for (int u = wg; u < 256; u += G) { if (u < 128) lin_unit<true>((lptr)lds, p, l, u >> 3, u & 7, 1, u); else lin_unit<false>((lptr)lds, p, l, (u - 128) >> 3, u & 7, 1, u); }
        }
        SEAM(pb + 1);
        if (RUN(pb + 2)) { WSP();
            const float* gain = p.in[7] + l * 512;
            REP(4) if (EN(4)) for (int u = wg; u < 256; u += G) {
                const int xcd = u & 7, idx = u >> 3, bh = xcd * 2 + (idx >> 4), pr = idx & 15;
#pragma nounroll
                for (int k2 = 0; k2 < 2; ++k2) attn_unit16((lptr)lds, Qb, KVb, KRb, YC, bh >> 2, bh & 3, k2 ? pr : 31 - pr, k2 != 0);
            }
            REP(5) if (EN(5)) for (int u = wg; u < 256; u += G) { if (u < 128) lin_unit<true>((lptr)lds, p, l, u >> 3, u & 7, 2, u); else lin_unit<false>((lptr)lds, p, l, (u - 128) >> 3, u & 7, 2, u); }
        }
        SEAM(pb + 2);
        if (EN(6) && RUN(pb + 3)) { WSP();
            pg8::Gemm g{YC, (const bf16_t*)(wl_ + W_OUT), DM, DM, DM}; pg8::StaticOrder S; S.init(MTOK / 256, DM / 256, G, wg);
            REP(6) { pg8::EpiRes E{XB, ssqx, ldsl + LDS_X, (((REP_MASK >> 6) & 1) && rep_ == 0) ? (REP_NOEPI ? -1.f : 0.f) : 1.f};
            pg8::gemm_phase(ldsl + LDS_RING, g, S, E, (LAS float*)(ldsl + LDS_RS)); }
        }
        SEAM(pb + 3);
        if (EN(7) && RUN(pb + 4)) { WSP();
            pg8::Gemm g{XB, (const bf16_t*)(wl_ + W_UP), DM, DM, DM}; pg8::StaticOrder S; S.init(MTOK / 256, NUP / 256, G, wg);
            REP(7) { pg8::EpiUp E{Gb, ssqx, p.in[15] + (size_t)l * 3 * DFF, p.in[16] + (size_t)l * DFF, halo, heada, headb, ldsl + LDS_X, (REP_NOEPI && ((REP_MASK >> 7) & 1) && rep_ == 0) ? 1 : 0};
            pg8::gemm_phase(ldsl + LDS_RING, g, S, E, (LAS float*)(ldsl + LDS_RS)); }
        }
        SEAM(pb + 4);
        if (EN(9) && RUN(pb + 5)) { WSP();
            pg8::Gemm g{Gb, (const bf16_t*)(wl_ + W_DN), DFF, DFF, DFF}; pg8::StaticOrder S; S.init(MTOK / 256, DM / 256, G, wg);
            { const float* cw = p.in[15] + (size_t)l * 3 * DFF; const float* cb = p.in[16] + (size_t)l * DFF; const int tl = ltid();
              pg8::Unit uu; int prev = -1;
              for (int ui = 0; S.next(ui, uu); ++ui) { const int pm = uu.pm; if (pm == prev) continue; prev = pm;
                const bool fob = (pm % 32) == 0;
                for (int i = tl; i < 2 * (DFF / 4); i += 512) {
                    const int c = (i % (DFF / 4)) * 4, r = i / (DFF / 4);
                    const f32x4 zero = (f32x4){0.f, 0.f, 0.f, 0.f};
                    const f32x4 ac = *(const f32x4*)(heada + (size_t)(pm * 2 + r) * DFF + c), bq = *(const f32x4*)(headb + (size_t)(pm * 2 + r) * DFF + c);
                    const f32x4 h1 = fob ? zero : *(const f32x4*)(halo + (size_t)((pm - 1) * 2 + 1) * DFF + c), h0 = fob ? zero : *(const f32x4*)(halo + (size_t)((pm - 1) * 2 + 0) * DFF + c);
                    const f32x4 am1 = (r == 1) ? *(const f32x4*)(heada + (size_t)(pm * 2) * DFF + c) : h1, am2 = (r == 1) ? h1 : h0;
                    const f32x4 w0 = *(const f32x4*)(cw + c), w1 = *(const f32x4*)(cw + DFF + c), w2 = *(const f32x4*)(cw + 2 * DFF + c), bbv = *(const f32x4*)(cb + c);
                    float gv[4];
#pragma unroll
                    for (int j = 0; j < 4; ++j) gv[j] = silu_f(bbv[j] + w0[j] * am2[j] + w1[j] * am1[j] + w2[j] * ac[j]) * bq[j];
                    *(u32x2*)(Gb + (size_t)(pm * 256 + r) * DFF + c) = (u32x2){cvtpk(gv[0], gv[1]), cvtpk(gv[2], gv[3])};
                } }
              asm volatile("s_waitcnt vmcnt(0)" ::: "memory"); __syncthreads(); }
            REP(9) { pg8::EpiRes E{XB, ssqx, ldsl + LDS_X, (((REP_MASK >> 9) & 1) && rep_ == 0) ? (REP_NOEPI ? -1.f : 0.f) : 1.f};
            pg8::gemm_phase(ldsl + LDS_RING, g, S, E, (LAS float*)(ldsl + LDS_RS)); }
        }
        SEAM(pb + 5);
    }
    if (EN(10) && RUN(NPH - 1)) { const int l = 0; WSP();
        const float* fg = p.in[18]; const int tl = ltid(), lane = tl & 63, wv = tl >> 6;
        for (int row = wg * 8 + wv; row < MTOK; row += G * 8) {
            const f32x4 q = *(const f32x4*)(ssqx + (size_t)row * 4);
            const float rstd = __builtin_amdgcn_rsqf(((q[0] + q[1]) + (q[2] + q[3])) * (1.0f / 1024.0f) + EPS);
#pragma unroll
            for (int i = 0; i < 2; ++i) { const size_t o = (size_t)row * DM + i * 512 + lane * 8;
                const u32x4 w = *(const u32x4*)(XB + o);
                const f32x4 g0 = *(const f32x4*)(fg + i * 512 + lane * 8), g1 = *(const f32x4*)(fg + i * 512 + lane * 8 + 4);
                *(f32x4*)(p.out + o) = (f32x4){bflo(w[0]), bfhi(w[0]), bflo(w[1]), bfhi(w[1])} * rstd * g0;
                *(f32x4*)(p.out + o + 4) = (f32x4){bflo(w[2]), bfhi(w[2]), bflo(w[3]), bfhi(w[3])} * rstd * g1; }
        }
    }
#undef RUN
#undef SEAM
}

extern "C" void kernel_launch(void* const* d_in, const int* in_sizes, int n_in, void* d_out, int out_size, void* d_ws, size_t ws_size, hipStream_t stream) {
    static int grid = 0;
    if (grid == 0) {
        if (n_in != 19 || in_sizes[0] != MTOK * DM || out_size != MTOK * DM || ws_size < WS_END) {
            fprintf(stderr, "kernel_launch: unexpected problem (n_in %d, in0 %d, out %d, ws %zu < %zu); nothing launched\n", n_in, n_in > 0 ? in_sizes[0] : -1, out_size, ws_size, (size_t)WS_END); grid = -1; return; }
        int dev = 0, cus = 0, per_cu = 0;
        if (hipGetDevice(&dev) != hipSuccess || hipDeviceGetAttribute(&cus, hipDeviceAttributeMultiprocessorCount, dev) != hipSuccess) { grid = -1; return; }
        if (hipFuncSetAttribute((const void*)mk_fwd, hipFuncAttributeMaxDynamicSharedMemorySize, LDS_BYTES) != hipSuccess) { fprintf(stderr, "kernel_launch: hipFuncSetAttribute failed\n"); grid = -1; return; }
        if (hipOccupancyMaxActiveBlocksPerMultiprocessor(&per_cu, (const void*)mk_fwd, 512, LDS_BYTES) != hipSuccess || per_cu < 1) { fprintf(stderr, "kernel_launch: occupancy query says %d\n", per_cu); (void)hipGetLastError(); }
        grid = cus;
    }
    if (grid < 0) return;
    (void)hipMemsetAsync((char*)d_ws + WS_BAR, 0, 16384, stream);
    Params p{};
    for (int i = 0; i < 19; ++i) p.in[i] = (const float*)d_in[i];
    p.out = (float*)d_out; p.ws = (unsigned char*)d_ws;
#if ONE_LAUNCH
    p.ph_lo = 0; p.ph_hi = NPH;
    hipLaunchKernelGGL(mk_fwd, dim3(grid), dim3(512), LDS_BYTES, stream, p);
#else
    for (int k = 0; k < NPH; ++k) { p.ph_lo = k; p.ph_hi = k + 1; hipLaunchKernelGGL(mk_fwd, dim3(grid), dim3(512), LDS_BYTES, stream, p); }
#endif
}
```

```cpp
#include <hip/hip_runtime.h>
#include <cstdio>
#include <cstdint>

#ifndef ONE_LAUNCH
#define ONE_LAUNCH 1
#endif
#ifndef PMASK
#define PMASK 0xffff
#endif
#define EN(x) ((PMASK >> (x)) & 1)
#ifndef REP_MASK
#define REP_MASK 0
#endif
#ifndef LPROBE
#define LPROBE 0
#endif
#ifndef REP_NOEPI
#define REP_NOEPI 0
#endif
#define REP(x) for (int rep_ = 0; rep_ < 1 + ((REP_MASK >> (x)) & 1); ++rep_) if (rep_ == 0 || (xcd_barrier(bar), true))

#define LAS __attribute__((address_space(3)))
typedef unsigned short bf16_t;
typedef short bf16x8 __attribute__((ext_vector_type(8)));
typedef short s16x4 __attribute__((ext_vector_type(4)));
typedef float f32x4 __attribute__((ext_vector_type(4)));
typedef float f32x2 __attribute__((ext_vector_type(2)));
typedef float f32x16 __attribute__((ext_vector_type(16)));
typedef unsigned u32x4 __attribute__((ext_vector_type(4)));
typedef unsigned u32x2 __attribute__((ext_vector_type(2)));
typedef LAS char* lptr;

constexpr int DM = 1024, NB = 4, SEQ = 8192, DEPTH = 4, MTOK = NB * SEQ;
constexpr int NZ = 2304;
constexpr int ZC_CQ = 0, ZC_CKV = 384, ZC_KR = 640, ZC_GQ = 704, ZC_GK = 832, ZC_GV = 960, ZC_GLR = 1216, ZC_GG = 1232, ZC_RQ = 1488, ZC_RK = 1616, ZC_RV = 1744, ZC_PAD = 2000, ZC_RG = 2048, ZC_END = 2256;
constexpr int DFF = 2816, NUP = 2 * DFF;
constexpr int NQ = 768, NKV = 1024;
constexpr float EPS = 1e-6f;

constexpr size_t al256(size_t x) { return (x + 255) & ~(size_t)255; }
constexpr size_t WS_BAR = 0;
constexpr size_t WS_SSQX = 16384;
constexpr size_t WS_SSQQ = WS_SSQX + (size_t)MTOK * 16;
constexpr size_t WS_SSQKV = WS_SSQQ + 8;
constexpr size_t WS_ROPEM = WS_SSQQ + (size_t)MTOK * 16;
constexpr size_t WS_ROPER = WS_ROPEM + (size_t)SEQ * 32 * 2 * 4;
constexpr int SUM_STRIDE = 2048 + 64;
constexpr size_t WS_SUMG = WS_ROPER + (size_t)SEQ * 16 * 2 * 4;
constexpr size_t WS_SUMR = WS_SUMG + (size_t)128 * SUM_STRIDE * 4;
constexpr size_t WS_HALO = WS_SUMR + (size_t)128 * SUM_STRIDE * 4;
constexpr size_t WS_HEADA = WS_HALO + (size_t)128 * 2 * DFF * 4;
constexpr size_t WS_HEADB = WS_HEADA + (size_t)128 * 2 * DFF * 4;
constexpr size_t WS_W = al256(WS_HEADB + (size_t)128 * 2 * DFF * 4);
constexpr size_t W_IN = 0, W_UQ = W_IN + (size_t)NZ * DM * 2, W_UKV = W_UQ + (size_t)NQ * 384 * 2, W_OUT = W_UKV + (size_t)NKV * 256 * 2,
                 W_UP = W_OUT + (size_t)DM * DM * 2, W_DN = W_UP + (size_t)NUP * DM * 2, W_LAYER = W_DN + (size_t)DM * DFF * 2;
constexpr size_t WS_XB = al256(WS_W + DEPTH * W_LAYER);
constexpr size_t WS_YCAT = WS_XB + (size_t)MTOK * DM * 2;
constexpr size_t WS_KR = WS_YCAT + (size_t)MTOK * DM * 2;
constexpr size_t WS_Z = WS_KR + (size_t)MTOK * 64 * 2;
constexpr size_t WS_Q = WS_Z + (size_t)MTOK * NZ * 2;
constexpr size_t WS_KV = WS_Q + (size_t)MTOK * NQ * 2;
constexpr size_t WS_G = WS_Z;
constexpr size_t WS_END = WS_KV + (size_t)MTOK * NKV * 2;
static_assert(WS_G + (size_t)MTOK * DFF * 2 <= WS_END, "G alias");
constexpr size_t LIN_SCR = 16 * 2048 * 4 + 16 * 2048 * 2 + 16 * 32 * 4;
static_assert(LIN_SCR * 256 <= (size_t)MTOK * DM * 2, "lin scratch alias");

#define XB_TMO      128
#define XB_XCNT(j)  (256  + 64 * (j))
#define XB_XSUB(j)  (1280 + 64 * (j))
#define XB_XGEN(j)  (2304 + 64 * (j))
#define XB_TOP      3328
#define XB_TOPGEN   3392
#define XCD_BAR_WORDS 3456
#define XB_SPIN_CAP (1u << 20)

__device__ __forceinline__ unsigned xb_ld(unsigned* p)              { return __hip_atomic_load(p, __ATOMIC_RELAXED, __HIP_MEMORY_SCOPE_AGENT); }
__device__ __forceinline__ unsigned xb_add(unsigned* p, unsigned v) { return __hip_atomic_fetch_add(p, v, __ATOMIC_RELAXED, __HIP_MEMORY_SCOPE_AGENT); }
__device__ __forceinline__ unsigned xb_xcc_id() { return (unsigned)__builtin_amdgcn_s_getreg((3 << 11) | 20) & 0xFu; }
#define XB_SPIN(cond, bar) do { unsigned _sp = 0; while (cond) { __builtin_amdgcn_s_sleep(1); \
    if ((++_sp & 255u) == 0u) { if (xb_ld(&(bar)[XB_TMO])) break; if (_sp > XB_SPIN_CAP) { atomicAdd(&(bar)[XB_TMO], 1u); break; } } } } while (0)

struct XcdBarrier { unsigned* bar; unsigned x; volatile LAS unsigned* st; };

__device__ __forceinline__ XcdBarrier xcd_barrier_post(unsigned* bar, volatile LAS unsigned* st) {
    XcdBarrier b; b.bar = bar; b.x = xb_xcc_id(); b.st = st;
    if (threadIdx.x == 0) (void)xb_add(&bar[XB_XCNT(b.x)], 1u);
    return b;
}
__device__ __forceinline__ void xcd_barrier_complete(unsigned* bar, unsigned x, unsigned& nloc, unsigned& nx) {
    const unsigned G = gridDim.x * gridDim.y * gridDim.z;
    unsigned sum, cnt, mine, sp = 0u;
    for (;;) {
        sum = 0u; cnt = 0u; mine = 0u;
#pragma unroll
        for (unsigned j = 0; j < 16; ++j) { const unsigned c = xb_ld(&bar[XB_XCNT(j)]); sum += c; cnt += (c > 0u) ? 1u : 0u; mine = (j == x) ? c : mine; }
        if (sum == G) break;
        __builtin_amdgcn_s_sleep(1);
        if ((++sp & 255u) == 0u) { if (xb_ld(&bar[XB_TMO])) break; if (sp > XB_SPIN_CAP) { atomicAdd(&bar[XB_TMO], 1u); break; } }
    }
    nloc = mine > 0u ? mine : 1u; nx = cnt > 0u ? cnt : 1u;
}
__device__ __forceinline__ void xcd_barrier(const XcdBarrier& b) {
    asm volatile("s_waitcnt vmcnt(0)" ::: "memory");
    __syncthreads();
    if (threadIdx.x == 0) {
        unsigned* bar = b.bar;
        __builtin_amdgcn_s_waitcnt(0);
        unsigned nloc = b.st[0], nx = b.st[1];
        if (nloc == 0u) { xcd_barrier_complete(bar, b.x, nloc, nx); b.st[0] = nloc; b.st[1] = nx; }
        const unsigned old = xb_add(&bar[XB_XSUB(b.x)], 1u);
        const unsigned gen = old / nloc;
        if (old + 1u == (gen + 1u) * nloc) {
            __builtin_amdgcn_fence(__ATOMIC_RELEASE, "agent");
            asm volatile("s_waitcnt vmcnt(0)" ::: "memory");
            const unsigned og = xb_add(&bar[XB_TOP], 1u);
            const unsigned tg = og / nx;
            if (og + 1u == (tg + 1u) * nx) xb_add(&bar[XB_TOPGEN], 1u);
            else XB_SPIN(xb_ld(&bar[XB_TOPGEN]) == tg, bar);
            __builtin_amdgcn_fence(__ATOMIC_ACQUIRE, "agent");
            xb_add(&bar[XB_XGEN(b.x)], 1u);
            asm volatile("s_waitcnt vmcnt(0)" ::: "memory");
        } else {
            XB_SPIN(xb_ld(&bar[XB_XGEN(b.x)]) == gen, bar);
            __builtin_amdgcn_fence(__ATOMIC_ACQUIRE, "agent");
            asm volatile("s_waitcnt vmcnt(0)" ::: "memory");
        }
    }
    __syncthreads();
}

__device__ __forceinline__ unsigned cvtpk(float lo, float hi) { unsigned r; asm volatile("v_cvt_pk_bf16_f32 %0, %1, %2" : "=v"(r) : "v"(lo), "v"(hi)); return r; }
__device__ __forceinline__ float bf2f(bf16_t b) { return __uint_as_float(((unsigned)b) << 16); }
__device__ __forceinline__ float bflo(unsigned w) { return __uint_as_float(w << 16); }
__device__ __forceinline__ float bfhi(unsigned w) { return __uint_as_float(w & 0xffff0000u); }
__device__ __forceinline__ bf16_t f2bf(float f) { return (bf16_t)(cvtpk(f, f) & 0xffffu); }
__device__ __forceinline__ bf16x8 pack8(f32x4 a, f32x4 b) { u32x4 w = {cvtpk(a[0], a[1]), cvtpk(a[2], a[3]), cvtpk(b[0], b[1]), cvtpk(b[2], b[3])}; return *reinterpret_cast<bf16x8*>(&w); }
__device__ __forceinline__ int crow(int r, int hi) { return (r & 3) + 8 * (r >> 2) + 4 * hi; }
__device__ __forceinline__ float silu_f(float x) { return x * __builtin_amdgcn_rcpf(1.0f + __builtin_amdgcn_exp2f(-1.4426950408889634f * x)); }
__device__ __forceinline__ int ropedim(int p) { const int j = p >> 3, e = p & 7; return e < 4 ? 4 * j + e : 32 + 4 * j + (e - 4); }

__device__ __forceinline__ int ltid() { int t = threadIdx.x; asm volatile("" : "+v"(t)); return t; }
struct Params {
    const float* in[19]; float* out; unsigned char* ws; int ph_lo, ph_hi;
};

namespace pg8 {
constexpr int BM = 256, BK = 64, HALF = 128, HTB = HALF * BK * 2, STAGE_BYTES = 8 * HTB, NXCD = 8, WGM = 8;
__host__ __device__ __forceinline__ int lds_byte(int r, int c) { const int st = (r >> 4) * 2 + (c >> 5), rr = r & 15, cc = c & 31, ob = rr * 64 + cc * 2; return st * 1024 + (ob ^ (((ob >> 9) & 1) << 5)); }
__host__ __device__ __forceinline__ void stage_rc(int b, int& R, int& C) { const int st = b / 1024, sb = b % 1024, swz = sb ^ (((sb >> 9) & 1) << 5); R = (st >> 1) * 16 + swz / 64; C = (st & 1) * 32 + (swz % 64) / 2; }
__host__ __device__ __forceinline__ int perm32(int rho) { const int n = rho >> 4, i = rho & 15; return 8 * (i >> 2) + 4 * n + (i & 3); }
struct Unit { int pm, pn; };
struct Gemm { const bf16_t* A; const bf16_t* Bt; int lda, ldb, K; };
struct StaticOrder {
    int nM, nN, nwg, G, c, imax, pn0;
    __device__ __forceinline__ void init(int nM_, int nN_, int G_, int c_) { nM = nM_; nN = nN_; nwg = nM * nN; G = G_; c = c_; imax = 1 << 30; pn0 = 0; }
    __device__ __forceinline__ bool next(int i, Unit& u) const {
        const long L = (long)i * G + c; if (i >= imax || L >= nwg) return false;
        int wgid = (int)L; { const int q = nwg / NXCD, r = nwg % NXCD, xcd = wgid % NXCD, off = wgid / NXCD; wgid = (xcd < r ? xcd * (q + 1) : r * (q + 1) + (xcd - r) * q) + off; }
        const int nig = WGM * nN, gid = wgid / nig, fm = gid * WGM, gsz = (nM - fm) < WGM ? (nM - fm) : WGM;
        u.pm = fm + ((wgid % nig) % gsz); u.pn = (wgid % nig) / gsz + pn0; return true;
    }
};
__device__ __forceinline__ void rowsum_out(LAS unsigned char* xl, const float (&sA)[2][4], const float (&sB)[2][4], int wr, int wc, int fr, int fq,
                                           float* dA, int strA, float* dB, int strB, int row0) {
    LAS float* X = (LAS float*)xl;
#pragma unroll
    for (int ai = 0; ai < 2; ++ai)
#pragma unroll
        for (int m = 0; m < 4; ++m) {
            float a = sA[ai][m], b = sB[ai][m];
            a += __shfl_xor(a, 16); a += __shfl_xor(a, 32); b += __shfl_xor(b, 16); b += __shfl_xor(b, 32);
            const int rl = ai * 128 + wr * 64 + m * 16 + fr;
            if (fq == 0) { X[rl * 4 + wc] = a; X[(256 + rl) * 4 + wc] = b; }
        }
    asm volatile("s_waitcnt lgkmcnt(0)" ::: "memory"); __builtin_amdgcn_s_barrier(); asm volatile("" ::: "memory");
    const int t = ltid() & 255, s = t >> 7, rr = t & 127, rl = (rr >> 6) * 128 + wr * 64 + (rr & 63);
    const f32x4 v = *(const LAS f32x4*)(X + (s * 256 + rl) * 4);
    const float tot = (v[0] + v[1]) + (v[2] + v[3]);
    if (s == 0) { if (dA) dA[(size_t)(row0 + rl) * strA] = tot; } else { if (dB) dB[(size_t)(row0 + rl) * strB] = tot; }
}

struct EpiZ {
    bf16_t* Z; bf16_t* KR; const float* ssqx; float* ssqq; float* ssqkv; const float* rc; const float* rs; LAS unsigned char* xl; int skip;
    static constexpr int STAT_N = 4; static constexpr float STAT_INV = 1.0f / 1024.0f;
    __device__ __forceinline__ const float* stat() const { return ssqx; }
    __device__ __forceinline__ void operator()(f32x4 (&acc)[2][2][4][2], const Unit& u, int wr, int wc, int fr, int fq, const LAS f32x4* rs_) const {
        if (REP_MASK && skip) return;
        float sA[2][4], sB[2][4], rstd[2][4];
        const bool krope = (u.pn == 2) && (wc < 2);
        const int row0 = u.pm * BM + wr * 64 + fr, jq = 4 * wc + fq;
#pragma unroll
        for (int ai = 0; ai < 2; ++ai)
#pragma unroll
            for (int m = 0; m < 4; ++m) { const f32x4 q = rs_[ai * HALF + wr * 64 + m * 16 + fr]; rstd[ai][m] = __builtin_amdgcn_rsqf(((q[0] + q[1]) + (q[2] + q[3])) * (1.0f / 1024.0f) + EPS); }
        f32x4 cn = (f32x4){0.f, 0.f, 0.f, 0.f}, sn = cn;
        if (krope) { const int pos = row0 & (SEQ - 1); cn = *(const f32x4*)(rc + pos * 32 + 4 * jq); sn = *(const f32x4*)(rs + pos * 32 + 4 * jq); }
#pragma unroll
        for (int ai = 0; ai < 2; ++ai)
#pragma unroll
            for (int m = 0; m < 4; ++m) {
                const int row = row0 + ai * HALF + m * 16;
                const f32x4 c = cn, sv = sn;
                if (krope && !(ai == 1 && m == 3)) { const int nrow = row0 + ((ai * 4 + m + 1) >> 2) * HALF + ((m + 1) & 3) * 16, pos = nrow & (SEQ - 1);
                    cn = *(const f32x4*)(rc + pos * 32 + 4 * jq); sn = *(const f32x4*)(rs + pos * 32 + 4 * jq); }
                float ss[2];
#pragma unroll
                for (int bj = 0; bj < 2; ++bj) {
                    f32x4 v0 = acc[ai][bj][m][0] * rstd[ai][m], v1 = acc[ai][bj][m][1] * rstd[ai][m];
                    ss[bj] = (v0[0] * v0[0] + v0[1] * v0[1]) + (v0[2] * v0[2] + v0[3] * v0[3]) + (v1[0] * v1[0] + v1[1] * v1[1]) + (v1[2] * v1[2] + v1[3] * v1[3]);
                    const int col = u.pn * BM + bj * HALF + wc * 32 + 8 * fq;
                    if (bj == 1 && krope) {
                        const f32x4 o1 = v0 * c - v1 * sv, o2 = v1 * c + v0 * sv;
                        *(bf16x8*)(KR + (size_t)row * 64 + (col - ZC_KR)) = pack8(o1, o2);
                    } else {
                        *(bf16x8*)(Z + (size_t)row * NZ + col) = pack8(v0, v1);
                    }
                }
                sA[ai][m] = (u.pn == 0) ? ss[0] + ss[1] : ss[0]; sB[ai][m] = ss[1];
                __builtin_amdgcn_sched_barrier(0);
            }
        if (u.pn <= 2) {
            float* dA = (u.pn == 0) ? ssqq : (u.pn == 1 ? ssqq + 1 : ssqkv + 1);
            float* dB = (u.pn == 1) ? ssqkv : nullptr;
            rowsum_out(xl, sA, sB, wr, wc, fr, fq, dA, 4, dB, 4, u.pm * BM);
        }
    }
};
struct EpiQ {
    bf16_t* Q; const float* ssqq; const float* rc; const float* rs;
    static constexpr int STAT_N = 4; static constexpr float STAT_INV = 1.0f / 384.0f;
    __device__ __forceinline__ const float* stat() const { return ssqq; }
    __device__ __forceinline__ void operator()(f32x4 (&acc)[2][2][4][2], const Unit& u, int wr, int wc, int fr, int fq, const LAS f32x4* rs_) const {
        float rstd[2][4];
        const int row0 = u.pm * BM + wr * 64 + fr, jq = 4 * (wc & 1) + fq;
        const bool rp0 = ((4 * u.pn + (wc >> 1)) % 3) == 2, rp1 = ((4 * u.pn + 2 + (wc >> 1)) % 3) == 2, anyrope = rp0 || rp1;
#pragma unroll
        for (int ai = 0; ai < 2; ++ai)
#pragma unroll
            for (int m = 0; m < 4; ++m) { const f32x4 q = rs_[ai * HALF + wr * 64 + m * 16 + fr]; rstd[ai][m] = __builtin_amdgcn_rsqf((q[0] + q[1]) * (1.0f / 384.0f) + EPS); }
        f32x4 cn = (f32x4){0.f, 0.f, 0.f, 0.f}, sn = cn;
        if (anyrope) { const int pos = row0 & (SEQ - 1); cn = *(const f32x4*)(rc + pos * 32 + 4 * jq); sn = *(const f32x4*)(rs + pos * 32 + 4 * jq); }
#pragma unroll
        for (int ai = 0; ai < 2; ++ai)
#pragma unroll
            for (int m = 0; m < 4; ++m) {
                const int row = row0 + ai * HALF + m * 16;
                const f32x4 c = cn, sv = sn;
                if (anyrope && !(ai == 1 && m == 3)) { const int nrow = row0 + ((ai * 4 + m + 1) >> 2) * HALF + ((m + 1) & 3) * 16, pos = nrow & (SEQ - 1);
                    cn = *(const f32x4*)(rc + pos * 32 + 4 * jq); sn = *(const f32x4*)(rs + pos * 32 + 4 * jq); }
#pragma unroll
                for (int bj = 0; bj < 2; ++bj) {
                    f32x4 v0 = acc[ai][bj][m][0] * rstd[ai][m], v1 = acc[ai][bj][m][1] * rstd[ai][m];
                    const int col = u.pn * BM + bj * HALF + wc * 32 + 8 * fq;
                    if (bj == 0 ? rp0 : rp1) { const f32x4 o1 = v0 * c - v1 * sv, o2 = v1 * c + v0 * sv; v0 = o1; v1 = o2; }
                    *(bf16x8*)(Q + (size_t)row * NQ + col) = pack8(v0, v1);
                }
                __builtin_amdgcn_sched_barrier(0);
            }
    }
};
struct EpiKV {
    bf16_t* KV; const float* ssqkv;
    static constexpr int STAT_N = 4; static constexpr float STAT_INV = 1.0f / 256.0f;
    __device__ __forceinline__ const float* stat() const { return ssqkv - 2; }
    __device__ __forceinline__ void operator()(f32x4 (&acc)[2][2][4][2], const Unit& u, int wr, int wc, int fr, int fq, const LAS f32x4* rs_) const {
        float rstd[2][4];
        const int row0 = u.pm * BM + wr * 64 + fr;
#pragma unroll
        for (int ai = 0; ai < 2; ++ai)
#pragma unroll
            for (int m = 0; m < 4; ++m) { const f32x4 q = rs_[ai * HALF + wr * 64 + m * 16 + fr]; rstd[ai][m] = __builtin_amdgcn_rsqf((q[2] + q[3]) * (1.0f / 256.0f) + EPS); }
#pragma unroll
        for (int ai = 0; ai < 2; ++ai)
#pragma unroll
            for (int m = 0; m < 4; ++m) {
                const int row = row0 + ai * HALF + m * 16;
#pragma unroll
                for (int bj = 0; bj < 2; ++bj) {
                    const int col = u.pn * BM + bj * HALF + wc * 32 + 8 * fq;
                    *(bf16x8*)(KV + (size_t)row * NKV + col) = pack8(acc[ai][bj][m][0] * rstd[ai][m], acc[ai][bj][m][1] * rstd[ai][m]);
                }
                __builtin_amdgcn_sched_barrier(0);
            }
    }
};
struct EpiRes {
    bf16_t* XB; float* ssqx; LAS unsigned char* xl; float sc;
    static constexpr int STAT_N = 0; static constexpr float STAT_INV = 0.f;
    __device__ __forceinline__ const float* stat() const { return nullptr; }
    __device__ __forceinline__ void operator()(f32x4 (&acc)[2][2][4][2], const Unit& u, int wr, int wc, int fr, int fq, const LAS f32x4*) const {
        float sA[2][4], sB[2][4];
        if (REP_MASK && sc < 0.f) return;
        const size_t o0 = (size_t)(u.pm * BM + wr * 64 + fr) * DM + u.pn * BM + wc * 32 + 8 * fq;
#ifndef RES_DEPTH
#define RES_DEPTH 4
#endif
        u32x4 nx[RES_DEPTH][2];
#pragma unroll
        for (int k = 0; k < RES_DEPTH; ++k)
#pragma unroll
            for (int bj = 0; bj < 2; ++bj) nx[k][bj] = *(const u32x4*)(XB + o0 + (size_t)((k >> 2) * HALF + (k & 3) * 16) * DM + bj * HALF);
#pragma unroll
        for (int ai = 0; ai < 2; ++ai)
#pragma unroll
            for (int m = 0; m < 4; ++m) {
                const int k = ai * 4 + m;
                const size_t orow = o0 + (size_t)(ai * HALF + m * 16) * DM;
                u32x4 cx[2];
#pragma unroll
                for (int bj = 0; bj < 2; ++bj) cx[bj] = nx[k % RES_DEPTH][bj];
                if (k + RES_DEPTH < 8) { const int kn = k + RES_DEPTH;
#pragma unroll
                    for (int bj = 0; bj < 2; ++bj) nx[k % RES_DEPTH][bj] = *(const u32x4*)(XB + o0 + (size_t)((kn >> 2) * HALF + (kn & 3) * 16) * DM + bj * HALF); }
                float ss = 0.f;
#pragma unroll
                for (int bj = 0; bj < 2; ++bj) {
                    const f32x4 x0 = (f32x4){bflo(cx[bj][0]), bfhi(cx[bj][0]), bflo(cx[bj][1]), bfhi(cx[bj][1])}, x1 = (f32x4){bflo(cx[bj][2]), bfhi(cx[bj][2]), bflo(cx[bj][3]), bfhi(cx[bj][3])};
                    const f32x4 v0 = x0 + acc[ai][bj][m][0] * sc, v1 = x1 + acc[ai][bj][m][1] * sc;
                    *(bf16x8*)(XB + orow + bj * HALF) = pack8(v0, v1);
                    ss += (v0[0] * v0[0] + v0[1] * v0[1]) + (v0[2] * v0[2] + v0[3] * v0[3]) + (v1[0] * v1[0] + v1[1] * v1[1]) + (v1[2] * v1[2] + v1[3] * v1[3]);
                }
                sA[ai][m] = ss; sB[ai][m] = 0.f;
                __builtin_amdgcn_sched_barrier(0);
            }
        rowsum_out(xl, sA, sB, wr, wc, fr, fq, ssqx + u.pn, 4, nullptr, 0, u.pm * BM);
    }
};
__device__ __forceinline__ float dpp_ror1(float v) { return __int_as_float(__builtin_amdgcn_mov_dpp(__float_as_int(v), 0x121, 0xf, 0xf, false)); }
__device__ __forceinline__ float dpp_ror2(float v) { return __int_as_float(__builtin_amdgcn_mov_dpp(__float_as_int(v), 0x122, 0xf, 0xf, false)); }
__device__ __forceinline__ float dpp_shr1(float old, float v) { return __int_as_float(__builtin_amdgcn_update_dpp(__float_as_int(old), __float_as_int(v), 0x111, 0xf, 0xf, false)); }
__device__ __forceinline__ float dpp_shr2(float old, float v) { return __int_as_float(__builtin_amdgcn_update_dpp(__float_as_int(old), __float_as_int(v), 0x112, 0xf, 0xf, false)); }
struct EpiUp {
    bf16_t* G; const float* ssqx; const float* cw; const float* cb; float* halo; float* heada; float* headb; LAS unsigned char* xl; int skip;
    static constexpr int STAT_N = 4; static constexpr float STAT_INV = 1.0f / 1024.0f;
    __device__ __forceinline__ const float* stat() const { return ssqx; }
    __device__ __forceinline__ void operator()(f32x4 (&acc)[2][2][4][2], const Unit& u, int wr, int wc, int fr, int fq, const LAS f32x4* rs_) const {
        if (REP_MASK && skip) return;
        LAS float* EX = (LAS float*)(xl + 8192);
        const int cbase = u.pn * HALF + wc * 32 + 8 * fq;
        f32x4 w0[2], w1[2], w2[2], bb[2];
#pragma unroll
        for (int n = 0; n < 2; ++n) { w0[n] = *(const f32x4*)(cw + cbase + 4 * n); w1[n] = *(const f32x4*)(cw + DFF + cbase + 4 * n); w2[n] = *(const f32x4*)(cw + 2 * DFF + cbase + 4 * n); bb[n] = *(const f32x4*)(cb + cbase + 4 * n); }
#pragma unroll
        for (int ai = 0; ai < 2; ++ai)
#pragma unroll
            for (int m = 0; m < 4; ++m) {
                const f32x4 q = rs_[ai * HALF + wr * 64 + m * 16 + fr];
                const float rstd = __builtin_amdgcn_rsqf(((q[0] + q[1]) + (q[2] + q[3])) * (1.0f / 1024.0f) + EPS);
#pragma unroll
                for (int bj = 0; bj < 2; ++bj) { acc[ai][bj][m][0] *= rstd; acc[ai][bj][m][1] *= rstd; }
            }
#pragma unroll
        for (int ai = 0; ai < 2; ++ai)
            if (fr >= 14) { LAS float* e = EX + ((((ai * 2 + wr) * 4 + wc) * 2 + (fr - 14)) * 32 + 8 * fq); *(LAS f32x4*)e = acc[ai][0][3][0]; *(LAS f32x4*)(e + 4) = acc[ai][0][3][1]; }
        asm volatile("s_waitcnt lgkmcnt(0)" ::: "memory"); __builtin_amdgcn_s_barrier(); asm volatile("" ::: "memory");
        __builtin_amdgcn_s_barrier(); asm volatile("" ::: "memory");
#pragma unroll
        for (int ai = 0; ai < 2; ++ai) {
            f32x4 pv[2];
            if (wr == 1 || ai == 1) {
                const int sai = (wr == 1) ? ai : 0, swr = (wr == 1) ? 0 : 1;
                const LAS float* e = EX + ((((sai * 2 + swr) * 4 + wc) * 2 + ((fr - 14) & 1)) * 32 + 8 * fq);
                pv[0] = *(const LAS f32x4*)e; pv[1] = *(const LAS f32x4*)(e + 4);
            } else { pv[0] = (f32x4){0.f, 0.f, 0.f, 0.f}; pv[1] = pv[0]; }
#pragma unroll
            for (int m = 0; m < 4; ++m) {
                const int row = u.pm * BM + ai * HALF + wr * 64 + m * 16 + fr;
                f32x4 gv[2];
#pragma unroll
                for (int n = 0; n < 2; ++n)
#pragma unroll
                    for (int j = 0; j < 4; j += 2) {
                        const f32x2 cur = {acc[ai][0][m][n][j], acc[ai][0][m][n][j + 1]};
                        const f32x2 u1 = {dpp_shr1(dpp_ror1(pv[n][j]), cur[0]), dpp_shr1(dpp_ror1(pv[n][j + 1]), cur[1])};
                        const f32x2 u2 = {dpp_shr2(dpp_ror2(pv[n][j]), cur[0]), dpp_shr2(dpp_ror2(pv[n][j + 1]), cur[1])};
                        const f32x2 W0 = {w0[n][j], w0[n][j + 1]}, W1 = {w1[n][j], w1[n][j + 1]}, W2 = {w2[n][j], w2[n][j + 1]}, BB = {bb[n][j], bb[n][j + 1]};
                        const f32x2 cv = __builtin_elementwise_fma(W2, cur, __builtin_elementwise_fma(W1, u1, __builtin_elementwise_fma(W0, u2, BB)));
                        const f32x2 tt = cv * -1.4426950408889634f;
                        f32x2 ee; ee[0] = __builtin_amdgcn_exp2f(tt[0]); ee[1] = __builtin_amdgcn_exp2f(tt[1]);
                        const f32x2 dd = ee + 1.0f;
                        f32x2 rr; rr[0] = __builtin_amdgcn_rcpf(dd[0]); rr[1] = __builtin_amdgcn_rcpf(dd[1]);
                        const f32x2 bq = {acc[ai][1][m][n][j], acc[ai][1][m][n][j + 1]};
                        const f32x2 g2 = (cv * rr) * bq;
                        gv[n][j] = g2[0]; gv[n][j + 1] = g2[1];
                    }
                const bool head = (ai == 0 && wr == 0 && m == 0 && fr < 2);
                if (!head) *(bf16x8*)(G + (size_t)row * DFF + cbase) = pack8(gv[0], gv[1]);
                else {
                    float* ha = heada + ((size_t)(u.pm * 2 + fr) * DFF + cbase); float* hb = headb + ((size_t)(u.pm * 2 + fr) * DFF + cbase);
                    *(f32x4*)ha = acc[0][0][0][0]; *(f32x4*)(ha + 4) = acc[0][0][0][1]; *(f32x4*)hb = acc[0][1][0][0]; *(f32x4*)(hb + 4) = acc[0][1][0][1];
                }
                if (ai == 1 && wr == 1 && m == 3 && fr >= 14) {
                    float* hl = halo + ((size_t)(u.pm * 2 + (fr - 14)) * DFF + cbase);
                    *(f32x4*)hl = acc[1][0][3][0]; *(f32x4*)(hl + 4) = acc[1][0][3][1];
                }
                pv[0] = acc[ai][0][m][0]; pv[1] = acc[ai][0][m][1];
                __builtin_amdgcn_sched_barrier(0);
            }
        }
    }
};

template <class Epi, class Sched>
__device__ __forceinline__ void gemm_phase(LAS unsigned char* lds, const Gemm g, const Sched& S, const Epi& E, LAS float* rsl) {
    int tid = threadIdx.x; asm volatile("" : "+v"(tid));
    const int wid = __builtin_amdgcn_readfirstlane(tid >> 6), lane = tid & 63, wr = wid >> 2, wc = wid & 3, fr = lane & 15, fq = lane >> 4;
    const int K = g.K, nt = K / BK;
    unsigned voffA[2], voffB[2];
#pragma unroll
    for (int i = 0; i < 2; ++i) { int R, C; stage_rc(tid * 16 + i * 8192, R, C); const int Rb = (R & ~31) + perm32(R & 31);
        voffA[i] = (unsigned)(R * g.lda + C) * 2u; voffB[i] = (unsigned)(Rb * g.ldb + C) * 2u; }
    const size_t kstep = (size_t)(BK * 2);
    const size_t hstepA = (size_t)HALF * g.lda * 2, hstepB = (size_t)HALF * g.ldb * 2;
    const size_t tstepA = 2 * hstepA, tstepB = 2 * hstepB;
    const unsigned ldsw = (unsigned)wid * 1024u;
    const int aoff = lds_byte(wr * 64 + fr, fq * 8), boff = lds_byte(wc * 32 + fr, fq * 8);
#define PG8_SA(b, h) (((b) * 2 + (h)) * HTB)
#define PG8_SB(b, h) ((4 + (b) * 2 + (h)) * HTB)
#define PG8_STAGE(bufoff, gbase, voff) do { _Pragma("unroll") for (int _i = 0; _i < 2; ++_i) \
        __builtin_amdgcn_global_load_lds((const unsigned*)((const char*)(gbase) + (voff)[_i]), (LAS unsigned*)(lds + (bufoff) + ldsw + _i * 8192), 16, 0, 0); } while (0)
#define PG8_LDA(dst, b, h) do { _Pragma("unroll") for (int m = 0; m < 4; ++m) _Pragma("unroll") for (int k = 0; k < 2; ++k) dst[m][k] = *(const LAS bf16x8*)(lds + PG8_SA(b, h) + aoff + m * 2048 + k * 1024); } while (0)
#define PG8_LDB(dst, b, h) do { _Pragma("unroll") for (int n = 0; n < 2; ++n) _Pragma("unroll") for (int k = 0; k < 2; ++k) dst[n][k] = *(const LAS bf16x8*)(lds + PG8_SB(b, h) + boff + n * 2048 + k * 1024); } while (0)
#define PG8_MMA(ai, bj, At, Bt) do { __builtin_amdgcn_s_setprio(1); _Pragma("unroll") for (int m = 0; m < 4; ++m) _Pragma("unroll") for (int n = 0; n < 2; ++n) _Pragma("unroll") for (int k = 0; k < 2; ++k) \
        acc[ai][bj][m][n] = __builtin_amdgcn_mfma_f32_16x16x32_bf16(Bt[n][k], At[m][k], acc[ai][bj][m][n], 0, 0, 0); __builtin_amdgcn_s_setprio(0); } while (0)
#define PG8_WAIT_V(n) asm volatile("s_waitcnt vmcnt(" #n ")" ::: "memory")
#define PG8_WAIT_L(n) asm volatile("s_waitcnt lgkmcnt(" #n ")" ::: "memory")
#define PG8_BAR __builtin_amdgcn_s_barrier()
#define PG8_SCHED __builtin_amdgcn_sched_barrier(0)
    Unit cur, nxt; int ui = 0;
    if (!S.next(0, cur)) return;
    f32x4 acc[2][2][4][2];
#pragma unroll
    for (int a = 0; a < 2; ++a)
#pragma unroll
        for (int b = 0; b < 2; ++b)
#pragma unroll
            for (int m = 0; m < 4; ++m)
#pragma unroll
                for (int n = 0; n < 2; ++n) acc[a][b][m][n] = (f32x4){0.f, 0.f, 0.f, 0.f};
    bf16x8 At[4][2], B0[2][2], B1[2][2];
    const char* cA = (const char*)g.A + (size_t)cur.pm * tstepA; const char* cB = (const char*)g.Bt + (size_t)cur.pn * tstepB;
#define PG8_STAT_DMA(pm_, bu_) do { if (Epi::STAT_N && wid < 4) __builtin_amdgcn_global_load_lds((const unsigned*)(E.stat() + (size_t)((pm_) * BM + tid) * 4), \
        (LAS unsigned*)((LAS unsigned char*)rsl + (bu_) * 4096 + wid * 1024), 16, 0, 0); } while (0)
    PG8_STAT_DMA(cur.pm, 0);
    PG8_STAGE(PG8_SB(0, 0), cB, voffB); PG8_STAGE(PG8_SA(0, 0), cA, voffA); PG8_STAGE(PG8_SB(0, 1), cB + hstepB, voffB); PG8_STAGE(PG8_SA(0, 1), cA + hstepA, voffA);
    if (wr == 1) PG8_BAR;
    PG8_WAIT_V(4); PG8_BAR;
    PG8_STAGE(PG8_SB(1, 0), cB + kstep, voffB); PG8_STAGE(PG8_SA(1, 0), cA + kstep, voffA); PG8_STAGE(PG8_SB(1, 1), cB + hstepB + kstep, voffB);
    PG8_WAIT_V(6); PG8_BAR;
    for (;;) {
        const bool has_next = S.next(ui + 1, nxt);
        if (has_next) PG8_STAT_DMA(nxt.pm, (ui + 1) % 3);
        const char* nA = has_next ? (const char*)g.A + (size_t)nxt.pm * tstepA : cA; const char* nB = has_next ? (const char*)g.Bt + (size_t)nxt.pn * tstepB : cB;
#pragma nounroll
        for (int t = 0; t < nt; t += 2) {
            const bool last = (t == nt - 2);
            const char* a1 = cA + (size_t)(t + 1) * kstep;
            const char* a2 = last ? nA : cA + (size_t)(t + 2) * kstep; const char* b2 = last ? nB : cB + (size_t)(t + 2) * kstep;
            const char* a3 = a2 + kstep; const char* b3 = b2 + kstep;
            PG8_LDB(B0, 0, 0); PG8_SCHED; PG8_LDA(At, 0, 0); PG8_STAGE(PG8_SA(1, 1), a1 + hstepA, voffA);
            PG8_WAIT_L(8); PG8_BAR; PG8_WAIT_L(0); PG8_MMA(0, 0, At, B0); PG8_BAR; PG8_SCHED;
            PG8_LDB(B1, 0, 1); PG8_STAGE(PG8_SB(0, 0), b2, voffB);
            PG8_BAR; PG8_WAIT_L(0); PG8_MMA(0, 1, At, B1); PG8_BAR;
            PG8_LDA(At, 0, 1); PG8_STAGE(PG8_SA(0, 0), a2, voffA);
            PG8_BAR; PG8_WAIT_L(0); PG8_MMA(1, 0, At, B0); PG8_BAR; PG8_SCHED;
            PG8_STAGE(PG8_SB(0, 1), b2 + hstepB, voffB);
            PG8_WAIT_V(6); PG8_BAR; PG8_MMA(1, 1, At, B1); PG8_BAR;
            PG8_LDB(B0, 1, 0); PG8_SCHED; PG8_LDA(At, 1, 0); PG8_STAGE(PG8_SA(0, 1), a2 + hstepA, voffA);
            PG8_WAIT_L(8); PG8_BAR; PG8_WAIT_L(0); PG8_MMA(0, 0, At, B0); PG8_BAR; PG8_SCHED;
            PG8_LDB(B1, 1, 1); PG8_STAGE(PG8_SB(1, 0), b3, voffB);
            PG8_BAR; PG8_WAIT_L(0); PG8_MMA(0, 1, At, B1); PG8_BAR;
            PG8_LDA(At, 1, 1); PG8_STAGE(PG8_SA(1, 0), a3, voffA);
            PG8_BAR; PG8_WAIT_L(0); PG8_MMA(1, 0, At, B0); PG8_BAR; PG8_SCHED;
            PG8_STAGE(PG8_SB(1, 1), b3 + hstepB, voffB);
            PG8_WAIT_V(6); PG8_BAR; PG8_MMA(1, 1, At, B1); PG8_BAR;
        }
        { int t_ = tid; asm volatile("" : "+v"(t_));
          E(acc, cur, wr, wc, t_ & 15, (t_ & 63) >> 4, (const LAS f32x4*)rsl + (ui % 3) * 256); }
        if (!has_next) break;
#pragma unroll
        for (int a = 0; a < 2; ++a)
#pragma unroll
            for (int b = 0; b < 2; ++b)
#pragma unroll
                for (int m = 0; m < 4; ++m)
#pragma unroll
                    for (int n = 0; n < 2; ++n) acc[a][b][m][n] = (f32x4){0.f, 0.f, 0.f, 0.f};
        cur = nxt; cA = nA; cB = nB; ++ui;
    }
    PG8_WAIT_V(0);
    if (wr == 0) PG8_BAR;
    PG8_BAR;
#undef PG8_STAT_DMA
#undef PG8_SA
#undef PG8_SB
#undef PG8_STAGE
#undef PG8_LDA
#undef PG8_LDB
#undef PG8_MMA
#undef PG8_WAIT_V
#undef PG8_WAIT_L
#undef PG8_BAR
#undef PG8_SCHED
}
}

__device__ __forceinline__ int srccol(int kind, int n) {
    if (kind == 0) { if (n >= ZC_PAD && n < ZC_RG) return -1; if (n >= ZC_RG) return n - (ZC_RG - ZC_PAD); if (n >= ZC_KR && n < ZC_KR + 64) return ZC_KR + ropedim(n - ZC_KR); return n; }
    if (kind == 1) { const int h = n / 192, w = n % 192; return w < 128 ? n : h * 192 + 128 + ropedim(w - 128); }
    if (kind == 4) { const int pn = n >> 8, w = n & 255; return w < 128 ? 128 * pn + w : DFF + 128 * pn + (w - 128); }
    return n;
}
__device__ __forceinline__ int tile_src0(int kind, int n0) {
    if (kind == 4) { const int pn = n0 >> 8, w = n0 & 255; return w < 128 ? 128 * pn + w : DFF + 128 * pn + (w - 128); }
    if (kind == 0 && n0 >= ZC_RG) return n0 - (ZC_RG - ZC_PAD);
    return n0;
}
__device__ __forceinline__ bool tile_is_rope(int kind, int n0) { return (kind == 0 && n0 == ZC_KR) || (kind == 1 && (n0 % 192) == 128); }
struct WTile { const float* src; const float* gain; bf16_t* dst; int K, nsrc, n0, k0, s0, ncols; float scale; bool rope; };
__device__ __forceinline__ void wtile_decode(const Params& p, int it, WTile& t) {
    constexpr int TN[6] = {NZ / 64, NQ / 64, NKV / 64, DM / 64, NUP / 64, DM / 64};
    constexpr int TK[6] = {DM / 64, 384 / 64, 256 / 64, DM / 64, DM / 64, DFF / 64};
    constexpr int NSRC[6] = {ZC_END, NQ, NKV, DM, NUP, DM};
    constexpr size_t WOFF[6] = {W_IN, W_UQ, W_UKV, W_OUT, W_UP, W_DN};
    constexpr int SRCI[6] = {2, 4, 6, 12, 14, 17};
    constexpr int GAINI[6] = {1, 3, 5, -1, 13, -1};
    int cum[7]; cum[0] = 0;
#pragma unroll
    for (int k = 0; k < 6; ++k) cum[k + 1] = cum[k] + TN[k] * TK[k];
    const int per_layer = cum[6];
    const int l = it / per_layer; int r = it % per_layer, kind = 0;
#pragma unroll
    for (int k = 1; k < 6; ++k) if (r >= cum[k]) kind = k;
    int tk = 0, nsrc = 0, gi = -1, si = 0; size_t woff = 0;
#pragma unroll
    for (int k = 0; k < 6; ++k) if (kind == k) { r -= cum[k]; tk = TK[k]; nsrc = NSRC[k]; gi = GAINI[k]; si = SRCI[k]; woff = WOFF[k]; }
    t.K = tk * 64; t.nsrc = nsrc; t.n0 = (r / tk) * 64; t.k0 = (r % tk) * 64;
    t.src = p.in[si] + (size_t)l * t.K * nsrc; t.gain = gi >= 0 ? p.in[gi] + (size_t)l * t.K : nullptr;
    if (kind == 3) t.gain = t.k0 < 512 ? p.in[7] + l * 512 : (t.k0 < 768 ? p.in[10] + l * 256 - 512 : p.in[11] + l * 256 - 768);
    t.scale = (kind == 1) ? 0.10411755f   : 1.0f;
    t.dst = (bf16_t*)(p.ws + WS_W + (size_t)l * W_LAYER + woff);
    t.s0 = tile_src0(kind, t.n0); t.rope = tile_is_rope(kind, t.n0);
    t.ncols = (nsrc - t.s0) < 64 ? (nsrc - t.s0) : 64;
    if (kind == 0 && t.n0 < ZC_RG) t.ncols = (ZC_PAD - t.n0) < 64 ? (ZC_PAD - t.n0) : 64;
}
constexpr int W_TILES_PER_LAYER = (NZ / 64) * (DM / 64) + (NQ / 64) * 6 + (NKV / 64) * 4 + (DM / 64) * (DM / 64) + (NUP / 64) * (DM / 64) + (DM / 64) * (DFF / 64);
__device__ __forceinline__ void wconvert(const Params& p, lptr lds, int it, const int NT) {
    const int tid = ltid(), G = gridDim.x;
    LAS float* tile = (LAS float*)lds;
    const int lk = tid >> 4, ln = (tid & 15) * 4;
    const int sn = tid >> 3, sk = (tid & 7) * 8;
    WTile t; f32x4 v0, v1; float g0 = 1.f, g1 = 1.f;
    if (it < NT) {
        wtile_decode(p, it, t);
        const bool ok = ln < t.ncols;
        v0 = ok ? *(const f32x4*)(t.src + (size_t)(t.k0 + lk) * t.nsrc + t.s0 + ln) : (f32x4){0.f, 0.f, 0.f, 0.f};
        v1 = ok ? *(const f32x4*)(t.src + (size_t)(t.k0 + lk + 32) * t.nsrc + t.s0 + ln) : (f32x4){0.f, 0.f, 0.f, 0.f};
        if (t.gain) { g0 = t.gain[t.k0 + lk]; g1 = t.gain[t.k0 + lk + 32]; }
    }
    while (it < NT) {
        const WTile c = t; const f32x4 c0 = v0 * (g0 * c.scale), c1 = v1 * (g1 * c.scale);
        const int nit = it + G;
        if (nit < NT) {
            wtile_decode(p, nit, t);
            const bool ok = ln < t.ncols;
            v0 = ok ? *(const f32x4*)(t.src + (size_t)(t.k0 + lk) * t.nsrc + t.s0 + ln) : (f32x4){0.f, 0.f, 0.f, 0.f};
            v1 = ok ? *(const f32x4*)(t.src + (size_t)(t.k0 + lk + 32) * t.nsrc + t.s0 + ln) : (f32x4){0.f, 0.f, 0.f, 0.f};
            g0 = 1.f; g1 = 1.f; if (t.gain) { g0 = t.gain[t.k0 + lk]; g1 = t.gain[t.k0 + lk + 32]; }
        }
        __syncthreads();
#pragma unroll
        for (int j = 0; j < 4; ++j) { tile[lk * 65 + ln + j] = c0[j]; tile[(lk + 32) * 65 + ln + j] = c1[j]; }
        __syncthreads();
        { const int scol = c.rope ? ropedim(sn) : sn;
          f32x4 a, b;
#pragma unroll
          for (int j = 0; j < 4; ++j) { a[j] = tile[(sk + j) * 65 + scol]; b[j] = tile[(sk + 4 + j) * 65 + scol]; }
          *(bf16x8*)(c.dst + (size_t)(c.n0 + sn) * c.K + c.k0 + sk) = pack8(a, b); }
        it = nit;
    }
    __syncthreads();
}
constexpr int CV_LDS = 83968;
__device__ __forceinline__ void cv_issue(const Params& p, lptr lds, int it, int buf, int tid, int wid) {
    WTile t; wtile_decode(p, it, t);
    const int L = tid & 63;
#pragma unroll
    for (int i = 0; i < 2; ++i) { const int row = 4 * wid + (L >> 4) + 32 * i;
        const float* src = t.src + (size_t)(t.k0 + row) * t.nsrc + t.s0 + (L & 15) * 4;
        __builtin_amdgcn_global_load_lds((const unsigned*)src, (LAS unsigned*)(lds + CV_LDS + buf * 16384 + i * 8192 + wid * 1024), 16, 0, 0); }
}
__device__ __forceinline__ void cv_finish(const Params& p, lptr lds, int it, int buf, int tid, int wid) {
    WTile t; wtile_decode(p, it, t);
    const int n = tid & 63, kb8 = 8 * wid, scol = t.rope ? ropedim(n) : n;
    const LAS float* tile = (const LAS float*)(lds + CV_LDS + buf * 16384);
    f32x4 a, b, ga = (f32x4){1.f, 1.f, 1.f, 1.f}, gb = ga;
    if (t.gain) { ga = *(const f32x4*)(t.gain + t.k0 + kb8); gb = *(const f32x4*)(t.gain + t.k0 + kb8 + 4); }
#pragma unroll
    for (int j = 0; j < 4; ++j) { a[j] = tile[(kb8 + j) * 64 + scol]; b[j] = tile[(kb8 + 4 + j) * 64 + scol]; }
    const float z = scol < t.ncols ? t.scale : 0.f;
    *(bf16x8*)(t.dst + (size_t)(t.n0 + n) * t.K + t.k0 + kb8) = pack8(a * ga * z, b * gb * z);
}
__device__ __forceinline__ void prologue(const Params& p, lptr lds) {
    const int tid = ltid(), G = gridDim.x, wg = blockIdx.x;
    wconvert(p, lds, wg, W_TILES_PER_LAYER);
    { const float* x = p.in[0]; bf16_t* XB = (bf16_t*)(p.ws + WS_XB); float* ssqx = (float*)(p.ws + WS_SSQX);
      const int lane = tid & 63, wv = tid >> 6;
      for (int row = wg * 8 + wv; row < MTOK; row += G * 8) {
          float ss = 0.f;
#pragma unroll
          for (int i = 0; i < 2; ++i) { const size_t o = (size_t)row * DM + i * 512 + lane * 8;
              const f32x4 a = *(const f32x4*)(x + o), b = *(const f32x4*)(x + o + 4);
              *(bf16x8*)(XB + o) = pack8(a, b);
              ss += (a[0] * a[0] + a[1] * a[1]) + (a[2] * a[2] + a[3] * a[3]) + (b[0] * b[0] + b[1] * b[1]) + (b[2] * b[2] + b[3] * b[3]); }
#pragma unroll
          for (int o = 32; o > 0; o >>= 1) ss += __shfl_xor(ss, o);
          if (lane == 0) *(f32x4*)(ssqx + (size_t)row * 4) = (f32x4){ss, 0.f, 0.f, 0.f};
      } }
    { float* rcm = (float*)(p.ws + WS_ROPEM); float* rsm = rcm + SEQ * 32; float* rcr = (float*)(p.ws + WS_ROPER); float* rsr = rcr + SEQ * 16;
      for (int i = wg * 512 + tid; i < SEQ * 48; i += G * 512) {
          const bool mla = i < SEQ * 32; const int j = mla ? i : i - SEQ * 32; const int half = mla ? 32 : 16; const int pos = j / half, f = j % half;
          const float inv = (float)exp2(-(double)f / (double)half * 13.287712379549449);
          const float ang = (float)pos * inv;
          const double rev = (double)ang * 0.15915494309189535; const float fr_ = (float)(rev - rint(rev));
          const float c = __builtin_amdgcn_cosf(fr_), s = __builtin_amdgcn_sinf(fr_);
          if (mla) { rcm[j] = c; rsm[j] = s; } else { rcr[j] = c; rsr[j] = s; }
      } }
}

constexpr int AT_KN = 0, AT_KR = 32768, AT_V = 49152, AT_WS = 81920, AT_LDS = 81920 + 8 * 256;
constexpr int SHM_V = 16384;
__device__ __forceinline__ int v_st(int k, int c) { const int kk = (k & ~0xC) | ((k & 4) << 1) | ((k & 8) >> 1); return ((kk >> 3) * 4 + (c >> 5)) * 512 + ((kk & 7) * 32 + (c & 31)) * 2; }
__device__ __forceinline__ int v_rd_base(int lane) { return ((lane & 3) << 3) | (((lane >> 2) & 3) << 6) | (((lane >> 4) & 1) << 5) | (((lane >> 5) & 1) << 8); }
#define KN_OFF(row, ch) ((row) * 256 + ((((ch) ^ ((row) & 15))) << 4))
#define KR_OFF(row, ch) ((row) * 128 + ((((ch) ^ (((row) >> 1) & 7))) << 4))
#define PK4(P, B_, OUT) do { unsigned a0 = cvtpk(P[B_+0], P[B_+1]), a1 = cvtpk(P[B_+2], P[B_+3]);                          \
        unsigned b0 = cvtpk(P[B_+4], P[B_+5]), b1 = cvtpk(P[B_+6], P[B_+7]);                                             \
        auto r0 = __builtin_amdgcn_permlane32_swap(a0, b0, false, false); auto r1 = __builtin_amdgcn_permlane32_swap(a1, b1, false, false); \
        u32x4 w = {r0[0], r1[0], r0[1], r1[1]}; OUT = *reinterpret_cast<bf16x8*>(&w); } while (0)
#define KRD128(dst, addr, off) asm volatile("ds_read_b128 %0, %1 offset:%2" : "=&v"(dst) : "v"(addr), "i"(off) : "memory")
#ifndef A16_RING
#define A16_RING 4
#endif
#define TRRD(dst, addr, off) asm volatile("ds_read_b64_tr_b16 %0, %1 offset:%2" : "=&v"(dst) : "v"(addr), "i"(off) : "memory")

__device__ __forceinline__ void attn_unit(lptr lds, const bf16_t* Q, const bf16_t* KV, const bf16_t* KRb, bf16_t* Y, const float* gain, int b, int h, int qb) {
    int tid = threadIdx.x; asm volatile("" : "+v"(tid));
    const int wid = __builtin_amdgcn_readfirstlane(tid >> 6), lane = tid & 63, r32 = lane & 31, hi = lane >> 5;
    const int P0 = qb * 256, tok0 = b * SEQ, NT = 4 * (qb + 1), w0 = P0 + wid * 32;
    volatile LAS float* wsc = (volatile LAS float*)(lds + AT_WS) + wid * 64;
    bf16x8 qf[12];
    { const bf16_t* qp = Q + (size_t)(tok0 + w0 + r32) * NQ + h * 192 + hi * 8;
#pragma unroll
      for (int d = 0; d < 12; ++d) qf[d] = *(const bf16x8*)(qp + d * 16); }
    const int sr = tid >> 4, scc = tid & 15, rr = tid >> 3, rch = tid & 7;
    const unsigned kvo = (unsigned)(((tok0 + sr) * NKV + h * 256 + scc * 8) * 2), kro = (unsigned)(((tok0 + rr) * 64 + rch * 8) * 2);
    const int kn_w = KN_OFF(sr, scc), kr_w = KR_OFF(rr, rch), v_w0 = v_st(sr, scc * 8), v_w1 = v_st(32 + sr, scc * 8);
    const int vb0 = (int)(unsigned)(size_t)(lds + AT_V) + v_rd_base(lane);
    bf16x8 sk0, sk1, sv0, sv1, skr;
#define AT_LOAD(t) do { const char* kb_ = (const char*)KV + (size_t)(t) * 64 * NKV * 2; const char* rb_ = (const char*)KRb + (size_t)(t) * 64 * 64 * 2; \
        sk0 = *(const bf16x8*)(kb_ + kvo); sk1 = *(const bf16x8*)(kb_ + 32 * NKV * 2 + kvo); \
        sv0 = *(const bf16x8*)(kb_ + 256 + kvo); sv1 = *(const bf16x8*)(kb_ + 32 * NKV * 2 + 256 + kvo); skr = *(const bf16x8*)(rb_ + kro); } while (0)
#define AT_WRITE(bf) do { *(LAS bf16x8*)(lds + AT_KN + (bf) * 16384 + kn_w) = sk0; *(LAS bf16x8*)(lds + AT_KN + (bf) * 16384 + kn_w + 32 * 256) = sk1; \
        *(LAS bf16x8*)(lds + AT_V + (bf) * SHM_V + v_w0) = sv0; *(LAS bf16x8*)(lds + AT_V + (bf) * SHM_V + v_w1) = sv1; *(LAS bf16x8*)(lds + AT_KR + (bf) * 8192 + kr_w) = skr; } while (0)
    float m_reg = -1e30f, l_reg = 0.f; f32x16 o[4];
#pragma unroll
    for (int d = 0; d < 4; ++d) o[d] = (f32x16){};
    AT_LOAD(0); AT_WRITE(0);
#pragma unroll
    for (int d = 0; d < 12; ++d) asm volatile("" : "+v"(qf[d]));
    __syncthreads();
    if (wid >= 4) __builtin_amdgcn_s_setprio(1);
    for (int t = 0; t < NT; ++t) {
        const int bf = t & 1, kb = t * 64;
        if (t + 1 < NT) AT_LOAD(t + 1);
        if (kb <= w0 + 31) {
            f32x16 p0 = (f32x16){}, p1 = (f32x16){};
            const lptr kn = lds + AT_KN + bf * 16384; const lptr kr = lds + AT_KR + bf * 8192;
            bf16x8 ka[2][4];
#define AT_KLOAD(g, bu) do { _Pragma("unroll") for (int dd = 0; dd < 2; ++dd) { const int d_ = 2 * (g) + dd; \
                if (d_ < 8) { ka[bu][2 * dd] = *(const LAS bf16x8*)(kn + KN_OFF(r32, 2 * d_ + hi)); ka[bu][2 * dd + 1] = *(const LAS bf16x8*)(kn + KN_OFF(r32, 2 * d_ + hi) + 32 * 256); } \
                else { ka[bu][2 * dd] = *(const LAS bf16x8*)(kr + KR_OFF(r32, 2 * (d_ - 8) + hi)); ka[bu][2 * dd + 1] = *(const LAS bf16x8*)(kr + KR_OFF(r32, 2 * (d_ - 8) + hi) + 32 * 128); } } } while (0)
#define AT_KMMA(g, bu) do { _Pragma("unroll") for (int dd = 0; dd < 2; ++dd) { \
                p0 = __builtin_amdgcn_mfma_f32_32x32x16_bf16(ka[bu][2 * dd], qf[2 * (g) + dd], p0, 0, 0, 0); p1 = __builtin_amdgcn_mfma_f32_32x32x16_bf16(ka[bu][2 * dd + 1], qf[2 * (g) + dd], p1, 0, 0, 0); } } while (0)
            AT_KLOAD(0, 0); __builtin_amdgcn_sched_barrier(0);
            AT_KLOAD(1, 1); __builtin_amdgcn_sched_barrier(0); AT_KMMA(0, 0); __builtin_amdgcn_sched_barrier(0);
            AT_KLOAD(2, 0); __builtin_amdgcn_sched_barrier(0); AT_KMMA(1, 1); __builtin_amdgcn_sched_barrier(0);
            AT_KLOAD(3, 1); __builtin_amdgcn_sched_barrier(0); AT_KMMA(2, 0); __builtin_amdgcn_sched_barrier(0);
            AT_KLOAD(4, 0); __builtin_amdgcn_sched_barrier(0); AT_KMMA(3, 1); __builtin_amdgcn_sched_barrier(0);
            AT_KLOAD(5, 1); __builtin_amdgcn_sched_barrier(0); AT_KMMA(4, 0); __builtin_amdgcn_sched_barrier(0);
            AT_KMMA(5, 1); __builtin_amdgcn_sched_barrier(0);
#undef AT_KLOAD
#undef AT_KMMA
            if (kb + 63 > w0) {
                const int dq = w0 + r32 - kb - 4 * hi;
                const float NEG = -__builtin_inff();
#pragma unroll
                for (int r = 0; r < 16; ++r) { const int c = (r & 3) + 8 * (r >> 2); if (c > dq) p0[r] = NEG; if (c + 32 > dq) p1[r] = NEG; }
            }
            float pmax = p0[0];
#pragma unroll
            for (int r = 1; r < 16; ++r) pmax = fmaxf(pmax, p0[r]);
#pragma unroll
            for (int r = 0; r < 16; ++r) pmax = fmaxf(pmax, p1[r]);
            { auto rr2 = __builtin_amdgcn_permlane32_swap(__float_as_uint(pmax), __float_as_uint(pmax), false, false); pmax = fmaxf(__uint_as_float(rr2[0]), __uint_as_float(rr2[1])); }
            if (!__all(pmax - m_reg <= 11.5f)) {
                const float mn = fmaxf(m_reg, pmax), alpha = __builtin_amdgcn_exp2f(m_reg - mn); m_reg = mn; l_reg *= alpha;
                if (hi == 0) wsc[r32] = alpha;
#pragma unroll
                for (int r = 0; r < 16; ++r) { const float al = wsc[crow(r, hi)];
#pragma unroll
                    for (int d = 0; d < 4; ++d) o[d][r] *= al; }
            }
            float ps = 0.f;
#pragma unroll
            for (int r = 0; r < 16; ++r) { p0[r] = __builtin_amdgcn_exp2f(p0[r] - m_reg); p1[r] = __builtin_amdgcn_exp2f(p1[r] - m_reg); ps += p0[r] + p1[r]; }
            { auto rr2 = __builtin_amdgcn_permlane32_swap(__float_as_uint(ps), __float_as_uint(ps), false, false); ps = __uint_as_float(rr2[0]) + __uint_as_float(rr2[1]); }
            l_reg += ps;
            bf16x8 pa0, pa1, pa2, pa3;
            PK4(p0, 0, pa0); PK4(p0, 8, pa1); PK4(p1, 0, pa2); PK4(p1, 8, pa3);
            const int vb = vb0 + bf * SHM_V;
            s16x4 vl[2][4], vh[2][4];
#define PV_RD(d0, se) do { constexpr int b_ = (d0) * 512; TRRD(vl[se][0], vb, b_); TRRD(vh[se][0], vb, b_ + 2048); TRRD(vl[se][1], vb, b_ + 4096); TRRD(vh[se][1], vb, b_ + 6144); \
            TRRD(vl[se][2], vb, b_ + 8192); TRRD(vh[se][2], vb, b_ + 10240); TRRD(vl[se][3], vb, b_ + 12288); TRRD(vh[se][3], vb, b_ + 14336); } while (0)
#define PV_MM(d0, se) do { \
            o[d0] = __builtin_amdgcn_mfma_f32_32x32x16_bf16(pa0, (bf16x8){vl[se][0][0], vl[se][0][1], vl[se][0][2], vl[se][0][3], vh[se][0][0], vh[se][0][1], vh[se][0][2], vh[se][0][3]}, o[d0], 0, 0, 0); \
            o[d0] = __builtin_amdgcn_mfma_f32_32x32x16_bf16(pa1, (bf16x8){vl[se][1][0], vl[se][1][1], vl[se][1][2], vl[se][1][3], vh[se][1][0], vh[se][1][1], vh[se][1][2], vh[se][1][3]}, o[d0], 0, 0, 0); \
            o[d0] = __builtin_amdgcn_mfma_f32_32x32x16_bf16(pa2, (bf16x8){vl[se][2][0], vl[se][2][1], vl[se][2][2], vl[se][2][3], vh[se][2][0], vh[se][2][1], vh[se][2][2], vh[se][2][3]}, o[d0], 0, 0, 0); \
            o[d0] = __builtin_amdgcn_mfma_f32_32x32x16_bf16(pa3, (bf16x8){vl[se][3][0], vl[se][3][1], vl[se][3][2], vl[se][3][3], vh[se][3][0], vh[se][3][1], vh[se][3][2], vh[se][3][3]}, o[d0], 0, 0, 0); } while (0)
            PV_RD(0, 0);
            PV_RD(1, 1); asm volatile("s_waitcnt lgkmcnt(8)" ::: "memory"); __builtin_amdgcn_sched_barrier(0); PV_MM(0, 0); __builtin_amdgcn_sched_barrier(0);
            PV_RD(2, 0); asm volatile("s_waitcnt lgkmcnt(8)" ::: "memory"); __builtin_amdgcn_sched_barrier(0); PV_MM(1, 1); __builtin_amdgcn_sched_barrier(0);
            PV_RD(3, 1); asm volatile("s_waitcnt lgkmcnt(8)" ::: "memory"); __builtin_amdgcn_sched_barrier(0); PV_MM(2, 0); __builtin_amdgcn_sched_barrier(0);
            asm volatile("s_waitcnt lgkmcnt(0)" ::: "memory"); __builtin_amdgcn_sched_barrier(0); PV_MM(3, 1);
#undef PV_RD
#undef PV_MM
#define PV_D0(x)
#undef PV_D0
        }
        if (t + 1 < NT) AT_WRITE(bf ^ 1);
        __syncthreads();
    }
#undef AT_LOAD
#undef AT_WRITE
    __builtin_amdgcn_s_setprio(0);
    if (hi == 0) wsc[r32] = l_reg;
    float rli[16];
#pragma unroll
    for (int r = 0; r < 16; ++r) rli[r] = __builtin_amdgcn_rcpf(wsc[crow(r, hi)]);
    (void)gain;
    bf16_t* yw = Y + (size_t)(tok0 + w0) * DM + h * 128;
#pragma unroll
    for (int r = 0; r < 16; ++r) {
        float v[4], ss = 0.f;
#pragma unroll
        for (int d = 0; d < 4; ++d) { v[d] = o[d][r] * rli[r]; ss += v[d] * v[d]; }
        ss += __shfl_xor(ss, 1); ss += __shfl_xor(ss, 2); ss += __shfl_xor(ss, 4); ss += __shfl_xor(ss, 8); ss += __shfl_xor(ss, 16);
        const float rstd = __builtin_amdgcn_rsqf(ss * (1.0f / 128.0f) + EPS);
        const int orow = crow(r, hi);
#pragma unroll
        for (int d = 0; d < 4; ++d) { const float y = v[d] * rstd; const float yn = __shfl_xor(y, 1);
            if ((r32 & 1) == 0) *(unsigned*)(yw + (size_t)orow * DM + d * 32 + r32) = cvtpk(y, yn); }
    }
    __syncthreads();
}

#define V16_OFF(row, c) ((row) * 256 + (((((c) >> 4) ^ ((row) & 7))) << 5) + (((c) >> 3) & 1) * 16)
__device__ __forceinline__ void attn_unit16(lptr lds, const bf16_t* Q, const bf16_t* KV, const bf16_t* KRb, bf16_t* Y, int b, int h, int qb, bool rev, const Params& cvp, int& cv_it, const int cv_end) {
    int tid = threadIdx.x; asm volatile("" : "+v"(tid));
    const int wid = __builtin_amdgcn_readfirstlane(tid >> 6), lane = tid & 63, c16 = lane & 15, fq = lane >> 4;
    const int P0 = qb * 256, tok0 = b * SEQ, NT = 4 * (qb + 1), w0 = P0 + wid * 32;
    volatile LAS float* wsc = (volatile LAS float*)(lds + AT_WS) + wid * 64;
    bf16x8 qf[2][6];
#pragma unroll
    for (int mb = 0; mb < 2; ++mb) { const bf16_t* qp = Q + (size_t)(tok0 + w0 + 16 * mb + c16) * NQ + h * 192 + 8 * fq;
#pragma unroll
        for (int s_ = 0; s_ < 6; ++s_) qf[mb][s_] = *(const bf16x8*)(qp + 32 * s_); }
    const int dl_ = tid & 63, rK = 4 * wid + (dl_ >> 4), pK = dl_ & 15, rR = 8 * wid + (dl_ >> 3), pR = dl_ & 7;
    const unsigned kn_src = (unsigned)(((tok0 + rK) * NKV + h * 256 + ((pK ^ (rK & 15)) << 3)) * 2);
    const unsigned v_src = (unsigned)(((tok0 + rK) * NKV + h * 256 + 128 + ((((pK >> 1) ^ (rK & 7)) << 4) + (pK & 1) * 8)) * 2);
    const unsigned kr_src = (unsigned)(((tok0 + rR) * 64 + ((pR ^ ((rR >> 1) & 7)) << 3)) * 2);
#define A16_GLDS(src, dst) __builtin_amdgcn_global_load_lds((const unsigned*)(src), (LAS unsigned*)(dst), 16, 0, 0)
#define A16_DMA(t, sl) do { const char* kb_ = (const char*)KV + (size_t)(t) * 64 * NKV * 2; const char* rb_ = (const char*)KRb + (size_t)(t) * 64 * 64 * 2; \
        A16_GLDS(kb_ + kn_src, lds + AT_KN + (sl) * 16384 + wid * 1024); A16_GLDS(kb_ + 32 * NKV * 2 + kn_src, lds + AT_KN + (sl) * 16384 + 8192 + wid * 1024); \
        A16_GLDS(rb_ + kr_src, lds + AT_KR + (sl) * 8192 + wid * 1024); \
        A16_GLDS(kb_ + v_src, lds + AT_V + (sl) * SHM_V + wid * 1024); A16_GLDS(kb_ + 32 * NKV * 2 + v_src, lds + AT_V + (sl) * SHM_V + 8192 + wid * 1024); } while (0)
    float m_ref[2] = {0.f, 0.f}, lsum[2] = {0.f, 0.f}; bool fresh = true;
    f32x4 o[2][8];
#pragma unroll
    for (int mb = 0; mb < 2; ++mb)
#pragma unroll
        for (int cb = 0; cb < 8; ++cb) o[mb][cb] = (f32x4){0.f, 0.f, 0.f, 0.f};
    A16_DMA(rev ? NT - 1 : 0, 0);
#pragma unroll
    for (int mb = 0; mb < 2; ++mb)
#pragma unroll
        for (int s_ = 0; s_ < 6; ++s_) asm volatile("" : "+v"(qf[mb][s_]));
    asm volatile("s_waitcnt vmcnt(0)" ::: "memory");
    __syncthreads();
    if (wid >= 4) __builtin_amdgcn_s_setprio(1);
    int cv_pend = -1, cvb = 0;
    for (int t = 0; t < NT; ++t) {
        const int bf = t & 1, tt = rev ? NT - 1 - t : t, kb = tt * 64;
        if (cv_pend >= 0) { cv_finish(cvp, lds, cv_pend, cvb ^ 1, tid, wid); cv_pend = -1; }
        if (t + 1 < NT) A16_DMA(rev ? tt - 1 : tt + 1, bf ^ 1);
        if (cv_it < cv_end) { cv_issue(cvp, lds, cv_it, cvb, tid, wid); cv_pend = cv_it; cv_it += (int)gridDim.x; cvb ^= 1; }
        if (kb <= w0 + 31) {
            int la_ = lane; asm volatile("" : "+v"(la_));
            const int c16a = la_ & 15, fqa = la_ >> 4;
            const lptr kn = lds + AT_KN + bf * 16384 + c16a * 256, kr = lds + AT_KR + bf * 8192 + c16a * 128;
            f32x4 sc[2][4];
#pragma unroll
            for (int mb = 0; mb < 2; ++mb) { const float nm_ = -m_ref[mb];
#pragma unroll
                for (int k4 = 0; k4 < 4; ++k4) sc[mb][k4] = (f32x4){nm_, nm_, nm_, nm_}; }
            int ka[6];
            { const int knb = (int)(unsigned)(size_t)kn, krb = (int)(unsigned)(size_t)kr;
#pragma unroll
              for (int s_ = 0; s_ < 4; ++s_) ka[s_] = knb + (((4 * s_ + fqa) ^ c16a) << 4);
#pragma unroll
              for (int s_ = 0; s_ < 2; ++s_) ka[4 + s_] = krb + (((4 * s_ + fqa) ^ ((c16a >> 1) & 7)) << 4); }
#define A16_KRD(dst, it_) do { const int k4_ = (it_) / 6, s__ = (it_) % 6; if (s__ < 4) KRD128(dst, ka[s__ < 4 ? s__ : 0], k4_ * 4096); else KRD128(dst, ka[s__ < 4 ? 4 : s__], k4_ * 2048); } while (0)
#define A16_KWAIT(n_, r_) asm volatile("s_waitcnt lgkmcnt(" #n_ ")" : "+v"(r_) :: "memory")
            bf16x8 kf[A16_RING];
#pragma unroll
            for (int it = 0; it < A16_RING - 1; ++it) A16_KRD(kf[it], it);
#pragma unroll
            for (int it = 0; it < 24; ++it) {
                const int k4 = it / 6, s_ = it % 6, ahead = it + A16_RING - 1 < 24 ? A16_RING - 1 : 23 - it;
                if (it + A16_RING - 1 < 24) A16_KRD(kf[(it + A16_RING - 1) % A16_RING], it + A16_RING - 1);
                if (ahead == 3) A16_KWAIT(3, kf[it % A16_RING]); else if (ahead == 2) A16_KWAIT(2, kf[it % A16_RING]); else if (ahead == 1) A16_KWAIT(1, kf[it % A16_RING]); else A16_KWAIT(0, kf[it % A16_RING]);
                sc[0][k4] = __builtin_amdgcn_mfma_f32_16x16x32_bf16(kf[it % A16_RING], qf[0][s_], sc[0][k4], 0, 0, 0);
                sc[1][k4] = __builtin_amdgcn_mfma_f32_16x16x32_bf16(kf[it % A16_RING], qf[1][s_], sc[1][k4], 0, 0, 0);
            }
#undef A16_KRD
#undef A16_KWAIT
            if (kb + 63 > w0) {
                const float NEG = -__builtin_inff();
#pragma unroll
                for (int mb = 0; mb < 2; ++mb) { const int dq = w0 + 16 * mb + c16 - kb - 4 * fq;
#pragma unroll
                    for (int k4 = 0; k4 < 4; ++k4)
#pragma unroll
                        for (int i = 0; i < 4; ++i) if (16 * k4 + i > dq) sc[mb][k4][i] = NEG; }
            }
            float lmax[2];
#pragma unroll
            for (int mb = 0; mb < 2; ++mb) { lmax[mb] = sc[mb][0][0];
#pragma unroll
                for (int k4 = 0; k4 < 4; ++k4)
#pragma unroll
                    for (int i = 0; i < 4; ++i) lmax[mb] = fmaxf(lmax[mb], sc[mb][k4][i]); }
            if (fresh || !__all((lmax[0] <= 11.5f) && (lmax[1] <= 11.5f))) {
#pragma unroll
                for (int mb = 0; mb < 2; ++mb) {
                    float rm = lmax[mb]; rm = fmaxf(rm, __shfl_xor(rm, 16)); rm = fmaxf(rm, __shfl_xor(rm, 32));
                    const float dl = fresh ? rm : fmaxf(rm, 0.f), alpha = fresh ? 1.0f : __builtin_amdgcn_exp2f(-dl); m_ref[mb] += dl; lsum[mb] *= alpha;
                    if (fq == 0) wsc[mb * 16 + c16] = alpha;
#pragma unroll
                    for (int k4 = 0; k4 < 4; ++k4)
#pragma unroll
                        for (int i = 0; i < 4; ++i) sc[mb][k4][i] -= dl;
                }
#pragma unroll
                for (int mb = 0; mb < 2; ++mb)
#pragma unroll
                    for (int i = 0; i < 4; ++i) { const float al = wsc[mb * 16 + 4 * fq + i];
#pragma unroll
                        for (int cb = 0; cb < 8; ++cb) o[mb][cb][i] *= al; }
            }
            bf16x8 pf[2][2];
#pragma unroll
            for (int mb = 0; mb < 2; ++mb) {
                float ps = 0.f;
#pragma unroll
                for (int k4 = 0; k4 < 4; ++k4)
#pragma unroll
                    for (int i = 0; i < 4; ++i) { sc[mb][k4][i] = __builtin_amdgcn_exp2f(sc[mb][k4][i]); ps += sc[mb][k4][i]; }
                lsum[mb] += ps;
#pragma unroll
                for (int g = 0; g < 2; ++g) { u32x4 w = {cvtpk(sc[mb][2 * g][0], sc[mb][2 * g][1]), cvtpk(sc[mb][2 * g][2], sc[mb][2 * g][3]), cvtpk(sc[mb][2 * g + 1][0], sc[mb][2 * g + 1][1]), cvtpk(sc[mb][2 * g + 1][2], sc[mb][2 * g + 1][3])};
                    pf[mb][g] = *reinterpret_cast<bf16x8*>(&w); }
            }
            const int tq_ = c16a >> 2, tp_ = c16a & 3, vrow_ = 4 * fqa + tq_;
            const int vbase = (int)(unsigned)(size_t)(lds + AT_V + bf * SHM_V) + vrow_ * 256 + 8 * tp_;
            const int vx = (vrow_ & 7) << 5;
            s16x4 va[2][2];
#define A16_VRD(g, cb, se) do { const int a_ = vbase + (vx ^ ((cb) << 5)); TRRD(va[se][0], a_, (g) * 8192); TRRD(va[se][1], a_, (g) * 8192 + 4096); } while (0)
#define A16_VWAIT(n_, se) asm volatile("s_waitcnt lgkmcnt(" #n_ ")" : "+v"(va[se][0]), "+v"(va[se][1]) :: "memory")
#define A16_VMM(g, cb, se) do { const bf16x8 vf_ = (bf16x8){va[se][0][0], va[se][0][1], va[se][0][2], va[se][0][3], va[se][1][0], va[se][1][1], va[se][1][2], va[se][1][3]}; \
                o[0][cb] = __builtin_amdgcn_mfma_f32_16x16x32_bf16(pf[0][g], vf_, o[0][cb], 0, 0, 0); o[1][cb] = __builtin_amdgcn_mfma_f32_16x16x32_bf16(pf[1][g], vf_, o[1][cb], 0, 0, 0); } while (0)
            A16_VRD(0, 0, 0);
#pragma unroll
            for (int it = 0; it < 16; ++it) {
                const int g = it >> 3, cb = it & 7;
                if (it + 1 < 16) { if ((it & 1) == 0) A16_VRD((it + 1) >> 3, (it + 1) & 7, 1); else A16_VRD((it + 1) >> 3, (it + 1) & 7, 0); }
                if (it + 1 < 16) { if ((it & 1) == 0) A16_VWAIT(2, 0); else A16_VWAIT(2, 1); } else { A16_VWAIT(0, 1); }
                if ((it & 1) == 0) A16_VMM(g, cb, 0); else A16_VMM(g, cb, 1);
            }
#undef A16_VRD
#undef A16_VWAIT
#undef A16_VMM
            fresh = false;
        }
        asm volatile("s_waitcnt vmcnt(0)" ::: "memory");
        __syncthreads();
    }
#undef A16_DMA
#undef A16_GLDS
    __builtin_amdgcn_s_setprio(0);
    if (cv_pend >= 0) cv_finish(cvp, lds, cv_pend, cvb ^ 1, tid, wid);
#pragma unroll
    for (int mb = 0; mb < 2; ++mb) { float l = lsum[mb]; l += __shfl_xor(l, 16); l += __shfl_xor(l, 32); if (fq == 0) wsc[mb * 16 + c16] = l; }
    bf16_t* yw = Y + (size_t)(tok0 + w0) * DM + h * 128 + c16;
#pragma unroll
    for (int mb = 0; mb < 2; ++mb)
#pragma unroll
        for (int i = 0; i < 4; ++i) {
            const float rl = __builtin_amdgcn_rcpf(wsc[mb * 16 + 4 * fq + i]);
            float v[8], ss = 0.f;
#pragma unroll
            for (int cb = 0; cb < 8; ++cb) { v[cb] = o[mb][cb][i] * rl; ss += v[cb] * v[cb]; }
            ss += __shfl_xor(ss, 1); ss += __shfl_xor(ss, 2); ss += __shfl_xor(ss, 4); ss += __shfl_xor(ss, 8);
            const float rstd = __builtin_amdgcn_rsqf(ss * (1.0f / 128.0f) + EPS);
            bf16_t* yr = yw + (size_t)(16 * mb + 4 * fq + i) * DM;
#pragma unroll
            for (int cb = 0; cb < 8; ++cb) { const float y = v[cb] * rstd; const float yn = __shfl_xor(y, 1);
                if ((c16 & 1) == 0) *(unsigned*)(yr + 16 * cb) = cvtpk(y, yn); }
        }
    __syncthreads();
}

constexpr int LW = 18688;
__device__ __forceinline__ float logsig(float x) { return fminf(x, 0.f) - __logf(1.0f + __expf(-fabsf(x))); }

template <bool GLA>
__device__ __forceinline__ void lin_stage(lptr wl, const bf16_t* Z, int tok, int h, int lane, bool need_q) {
    constexpr int QO = GLA ? ZC_GQ : ZC_RQ, KO = GLA ? ZC_GK : ZC_RK, VO = GLA ? ZC_GV : ZC_RV;
#pragma unroll
    for (int i = 0; i < 8; ++i) { const int idx = i * 64 + lane, row = idx >> 3, ch = idx & 7;
        *(LAS bf16x8*)(wl + 8192 + row * 128 + ch * 16) = *(const bf16x8*)(Z + (size_t)(tok + row) * NZ + VO + h * 64 + ch * 8); }
#pragma unroll
    for (int i = 0; i < 4; ++i) { const int idx = i * 64 + lane, row = idx >> 2, ch = idx & 3;
        *(LAS bf16x8*)(wl + 4096 + row * 64 + ch * 16) = *(const bf16x8*)(Z + (size_t)(tok + row) * NZ + KO + h * 32 + ch * 8);
        if (need_q) *(LAS bf16x8*)(wl + row * 64 + ch * 16) = *(const bf16x8*)(Z + (size_t)(tok + row) * NZ + QO + h * 32 + ch * 8); }
    if (GLA) {
#pragma unroll
        for (int i = 0; i < 2; ++i) { const int idx = i * 64 + lane, row = idx >> 1, ch = idx & 1;
            *(LAS bf16x8*)(wl + 16384 + row * 32 + ch * 16) = *(const bf16x8*)(Z + (size_t)(tok + row) * NZ + ZC_GLR + ch * 8); }
    }
}
template <bool GLA>
__device__ __forceinline__ void lin_decay(lptr wl, int lane, int pos0, bf16x8 wgf, float bgk, float log_g, const float* rcr, const float* rsr, bool need_q) {
    const int kk = lane & 31, hi = lane >> 5;
    f32x16 bb[2];
    if (GLA) {
#pragma unroll
        for (int blk = 0; blk < 2; ++blk) {
            const bf16x8 af = *(const LAS bf16x8*)(wl + 16384 + (32 * blk + kk) * 32 + hi * 16);
            bb[blk] = __builtin_amdgcn_mfma_f32_32x32x16_bf16(af, wgf, (f32x16){}, 0, 0, 0);
        }
        float T[8], Tp[8];
#pragma unroll
        for (int blk = 0; blk < 2; ++blk)
#pragma unroll
            for (int g = 0; g < 4; ++g) {
                float run = 0.f;
#pragma unroll
                for (int i = 0; i < 4; ++i) { run += logsig(bb[blk][4 * g + i] + bgk) * (1.0f / 16.0f); bb[blk][4 * g + i] = run; }
                T[blk * 4 + g] = run;
            }
#pragma unroll
        for (int s = 0; s < 8; ++s) Tp[s] = __shfl_xor(T[s], 32);
        float off = 0.f;
#pragma unroll
        for (int s = 0; s < 8; ++s) {
            const float o = off + (hi ? Tp[s] : 0.f);
#pragma unroll
            for (int i = 0; i < 4; ++i) bb[s >> 2][4 * (s & 3) + i] += o;
            off += T[s] + Tp[s];
        }
        if (hi == 0) *(LAS float*)(wl + 18432 + kk * 4) = __expf(off);
    } else {
        float lg = log_g; asm volatile("" : "+v"(lg));
#pragma unroll
        for (int blk = 0; blk < 2; ++blk)
#pragma unroll
            for (int r = 0; r < 16; ++r) bb[blk][r] = (float)(32 * blk + crow(r, hi) + 1) * lg;
        if (hi == 0) *(LAS float*)(wl + 18432 + kk * 4) = __expf(64.0f * lg);
    }
    constexpr float SC = 0.17677669529663687f;
    lptr ob = wl + ((4 * hi) * 32 + kk) * 2; lptr pb = wl + ((4 * hi) * 32 + (kk ^ 16)) * 2;
    asm volatile("" : "+v"(ob), "+v"(pb));
    const float* rc = rcr + (pos0 + 4 * hi) * 16 + (kk & 15); const float* rs = rsr + (pos0 + 4 * hi) * 16 + (kk & 15);
    float rcv[2][16], rsv[2][16];
    if (!GLA) {
#pragma unroll
        for (int blk = 0; blk < 2; ++blk)
#pragma unroll
            for (int r = 0; r < 16; ++r) { const int j0 = 32 * blk + (r & 3) + 8 * (r >> 2); rcv[blk][r] = rc[j0 * 16]; rsv[blk][r] = rs[j0 * 16]; }
    }
#pragma unroll
    for (int blk = 0; blk < 2; ++blk)
#pragma unroll
        for (int r = 0; r < 16; ++r) {
            const int j0 = 32 * blk + (r & 3) + 8 * (r >> 2);
            const float bj = bb[blk][r];
            float kv = bf2f(*(const LAS bf16_t*)(ob + 4096 + j0 * 64)), qv = need_q ? bf2f(*(const LAS bf16_t*)(ob + j0 * 64)) : 0.f;
            if (!GLA) {
                const float kp = bf2f(*(const LAS bf16_t*)(pb + 4096 + j0 * 64)), qp = need_q ? bf2f(*(const LAS bf16_t*)(pb + j0 * 64)) : 0.f;
                const float c = rcv[blk][r], sn = rsv[blk][r];
                kv = (kk < 16) ? kv * c - kp * sn : kv * c + kp * sn;
                qv = (kk < 16) ? qv * c - qp * sn : qv * c + qp * sn;
            }
            const float eb = __expf(bj), ei = __expf(-bj);
            *(LAS bf16_t*)(ob + 4096 + j0 * 64) = f2bf(kv * ei * (GLA ? 1.0f : SC));
            if (need_q) *(LAS bf16_t*)(ob + j0 * 64) = f2bf(qv * eb * (GLA ? SC : 1.0f));
            if ((r & 3) == 3) __builtin_amdgcn_sched_barrier(0);
        }
}

template <bool GLA>
__device__ __forceinline__ void lin_unit(lptr lds, const Params& p, int layer, int bh, int seg, int level, int unit) {
    int tid = threadIdx.x; asm volatile("" : "+v"(tid));
    const int wid = __builtin_amdgcn_readfirstlane(tid >> 6), lane = tid & 63, r32 = lane & 31, hi = lane >> 5;
    const int b = bh >> 2, h = bh & 3, tok0 = b * SEQ + seg * 1024;
    const bf16_t* Z = (const bf16_t*)(p.ws + WS_Z);
    lptr wl = lds + wid * LW;
    unsigned char* scr = (unsigned char*)p.out + (size_t)unit * LIN_SCR;
    float* Uc = (float*)scr; bf16_t* STc = (bf16_t*)(scr + 16 * 2048 * 4); float* Ec = (float*)(scr + 16 * 2048 * 4 + 16 * 2048 * 2);
    float* SUM = (float*)(p.ws + (GLA ? WS_SUMG : WS_SUMR));
    const float* rcr = (const float*)(p.ws + WS_ROPER); const float* rsr = rcr + SEQ * 16;
    bf16x8 wgf = (bf16x8){0, 0, 0, 0, 0, 0, 0, 0}; float bgk = 0.f;
    if (GLA) {
        const float* wg = p.in[8] + (size_t)layer * 16 * 128 + h * 32 + r32; bgk = p.in[9][layer * 128 + h * 32 + r32];
        f32x4 w0, w1;
#pragma unroll
        for (int i = 0; i < 4; ++i) { w0[i] = wg[(8 * hi + i) * 128]; w1[i] = wg[(8 * hi + 4 + i) * 128]; }
        wgf = pack8(w0, w1);
    }
    const float LG[4] = {-0.031748698314580298f, -0.015748356968139112f, -0.007843177461025893f, -0.003913899321136329f};
    const float log_g = h == 0 ? LG[0] : (h == 1 ? LG[1] : (h == 2 ? LG[2] : LG[3]));
    const int tg = lane >> 4, ti = lane & 15, tq = ti >> 2, tpq = ti & 3;
    const int ki_tr = (int)(unsigned)(size_t)(wl + 4096) + (8 * (tg >> 1) + tq) * 64 + (16 * (tg & 1) + 4 * tpq) * 2;
    const int vv_tr = (int)(unsigned)(size_t)(wl + 8192) + (8 * (tg >> 1) + tq) * 128 + (16 * (tg & 1) + 4 * tpq) * 2;
#pragma nounroll
    for (int ci_ = 0; ci_ < (level == 1 ? 2 + 2 * (LPROBE & 1) : 0); ++ci_) { const int ci = ci_ & 1;
        const int c = wid + 8 * ci;
        lin_stage<GLA>(wl, Z, tok0 + 64 * c, h, lane, false);
        lin_decay<GLA>(wl, lane, seg * 1024 + 64 * c, wgf, bgk, log_g, rcr, rsr, false);
        f32x16 u0 = (f32x16){}, u1 = (f32x16){};
#pragma unroll
        for (int s = 0; s < 4; ++s) {
            s16x4 al, ah, b0l, b0h, b1l, b1h;
            const int ka = ki_tr + s * 16 * 64, va = vv_tr + s * 16 * 128;
            TRRD(al, ka, 0); TRRD(ah, ka, 256); TRRD(b0l, va, 0); TRRD(b0h, va, 512); TRRD(b1l, va, 64); TRRD(b1h, va, 576);
            asm volatile("s_waitcnt lgkmcnt(0)" ::: "memory"); __builtin_amdgcn_sched_barrier(0);
            const bf16x8 af = (bf16x8){al[0], al[1], al[2], al[3], ah[0], ah[1], ah[2], ah[3]};
            u0 = __builtin_amdgcn_mfma_f32_32x32x16_bf16(af, (bf16x8){b0l[0], b0l[1], b0l[2], b0l[3], b0h[0], b0h[1], b0h[2], b0h[3]}, u0, 0, 0, 0);
            u1 = __builtin_amdgcn_mfma_f32_32x32x16_bf16(af, (bf16x8){b1l[0], b1l[1], b1l[2], b1l[3], b1h[0], b1h[1], b1h[2], b1h[3]}, u1, 0, 0, 0);
        }
        const LAS float* EB = (const LAS float*)(wl + 18432);
#pragma unroll
        for (int r = 0; r < 16; ++r) { const int kk = crow(r, hi); const float e = EB[kk];
            Uc[c * 2048 + kk * 64 + r32] = u0[r] * e; Uc[c * 2048 + kk * 64 + 32 + r32] = u1[r] * e; }
        if (lane < 32) Ec[c * 32 + lane] = EB[lane];
    }
    asm volatile("s_waitcnt vmcnt(0)" ::: "memory");
    __syncthreads();
    {
        const int vv = tid & 63, kk0 = (tid >> 6) * 4;
        float S[4] = {0.f, 0.f, 0.f, 0.f};
        if (level == 2) {
            float su_u[7][4], su_d[7][4];
#pragma unroll
            for (int sp = 0; sp < 7; ++sp) { const float* su = SUM + (size_t)(bh * 8 + (sp < seg ? sp : 0)) * SUM_STRIDE;
#pragma unroll
                for (int i = 0; i < 4; ++i) { su_u[sp][i] = su[(kk0 + i) * 64 + vv]; su_d[sp][i] = su[2048 + kk0 + i]; } }
#pragma unroll
            for (int sp = 0; sp < 7; ++sp) if (sp < seg) {
#pragma unroll
                for (int i = 0; i < 4; ++i) S[i] = su_d[sp][i] * S[i] + su_u[sp][i]; }
        }
        __builtin_amdgcn_sched_barrier(0);
        float dtot[4] = {1.f, 1.f, 1.f, 1.f};
#pragma unroll
        for (int hh = 0; hh < 2; ++hh) {
            float uu[8][4], ee[8][4];
#pragma unroll
            for (int c8 = 0; c8 < 8; ++c8)
#pragma unroll
                for (int i = 0; i < 4; ++i) { uu[c8][i] = Uc[(hh * 8 + c8) * 2048 + (kk0 + i) * 64 + vv]; ee[c8][i] = Ec[(hh * 8 + c8) * 32 + kk0 + i]; }
#pragma unroll
            for (int c8 = 0; c8 < 8; ++c8) {
                if (level == 2) *(u32x2*)(STc + (hh * 8 + c8) * 2048 + vv * 32 + kk0) = (u32x2){cvtpk(S[0], S[1]), cvtpk(S[2], S[3])};
#pragma unroll
                for (int i = 0; i < 4; ++i) { S[i] = ee[c8][i] * S[i] + uu[c8][i]; dtot[i] *= ee[c8][i]; }
            }
            __builtin_amdgcn_sched_barrier(0);
        }
        if (level == 1) { float* su = SUM + (size_t)(bh * 8 + seg) * SUM_STRIDE;
#pragma unroll
            for (int i = 0; i < 4; ++i) { su[(kk0 + i) * 64 + vv] = S[i]; if (vv == 0) su[2048 + kk0 + i] = dtot[i]; } }
    }
    asm volatile("s_waitcnt vmcnt(0)" ::: "memory");
    __syncthreads();
    if (level == 1) return;
    constexpr int GO = GLA ? ZC_GG : ZC_RG, YO = GLA ? 512 : 768;
    bf16_t* Y = (bf16_t*)(p.ws + WS_YCAT);
#pragma nounroll
    for (int ci_ = 0; ci_ < 2 + 2 * ((LPROBE >> 1) & 1); ++ci_) { const int ci = ci_ & 1;
        const int c = wid + 8 * ci, tok = tok0 + 64 * c;
        bf16x8 sfr[2][2];
#pragma unroll
        for (int s2 = 0; s2 < 2; ++s2) { sfr[s2][0] = *(const bf16x8*)(STc + c * 2048 + r32 * 32 + 16 * s2 + 8 * hi); sfr[s2][1] = *(const bf16x8*)(STc + c * 2048 + (32 + r32) * 32 + 16 * s2 + 8 * hi); }
        for (int sd_ = 0; sd_ < 1 + ((LPROBE >> 2) & 1); ++sd_) {
        lin_stage<GLA>(wl, Z, tok, h, lane, true);
        lin_decay<GLA>(wl, lane, seg * 1024 + 64 * c, wgf, bgk, log_g, rcr, rsr, true); }
        __builtin_amdgcn_sched_barrier(0);
        const bf16_t* gpb = Z + (size_t)(tok + r32) * NZ + GO + h * 64 + 4 * hi;
        u32x2 gt[2][8];
#pragma unroll
        for (int ib = 0; ib < 2; ++ib)
#pragma unroll
            for (int q8 = 0; q8 < 8; ++q8) gt[ib][q8] = *(const u32x2*)(gpb + (size_t)(32 * ib) * NZ + 32 * (q8 >> 2) + 8 * (q8 & 3));
        f32x16 pt00 = (f32x16){}, pt01 = (f32x16){}, pt11 = (f32x16){};
#pragma unroll
        for (int s2 = 0; s2 < 2; ++s2) {
            const bf16x8 k0f = *(const LAS bf16x8*)(wl + 4096 + r32 * 64 + (16 * s2 + 8 * hi) * 2), k1f = *(const LAS bf16x8*)(wl + 4096 + (32 + r32) * 64 + (16 * s2 + 8 * hi) * 2);
            const bf16x8 q0f = *(const LAS bf16x8*)(wl + r32 * 64 + (16 * s2 + 8 * hi) * 2), q1f = *(const LAS bf16x8*)(wl + (32 + r32) * 64 + (16 * s2 + 8 * hi) * 2);
            pt00 = __builtin_amdgcn_mfma_f32_32x32x16_bf16(k0f, q0f, pt00, 0, 0, 0);
            pt01 = __builtin_amdgcn_mfma_f32_32x32x16_bf16(k0f, q1f, pt01, 0, 0, 0);
            pt11 = __builtin_amdgcn_mfma_f32_32x32x16_bf16(k1f, q1f, pt11, 0, 0, 0);
        }
#pragma unroll
        for (int r = 0; r < 16; ++r) if (crow(r, hi) > r32) { pt00[r] = 0.f; pt11[r] = 0.f; }
        bf16x8 pa[2][4];
        PK4(pt00, 0, pa[0][0]); PK4(pt00, 8, pa[0][1]);
        PK4(pt01, 0, pa[1][0]); PK4(pt01, 8, pa[1][1]); PK4(pt11, 0, pa[1][2]); PK4(pt11, 8, pa[1][3]);
        f32x16 oT[2][2];
#pragma unroll
        for (int vb = 0; vb < 2; ++vb)
#pragma unroll
            for (int ib = 0; ib < 2; ++ib) oT[vb][ib] = (f32x16){};
#pragma unroll
        for (int ks = 0; ks < 4; ++ks) {
            s16x4 b0l, b0h, b1l, b1h; const int va = vv_tr + ks * 16 * 128;
            TRRD(b0l, va, 0); TRRD(b0h, va, 512); TRRD(b1l, va, 64); TRRD(b1h, va, 576);
            asm volatile("s_waitcnt lgkmcnt(0)" ::: "memory"); __builtin_amdgcn_sched_barrier(0);
            const bf16x8 vb0 = (bf16x8){b0l[0], b0l[1], b0l[2], b0l[3], b0h[0], b0h[1], b0h[2], b0h[3]}, vb1 = (bf16x8){b1l[0], b1l[1], b1l[2], b1l[3], b1h[0], b1h[1], b1h[2], b1h[3]};
            if (ks < 2) { oT[0][0] = __builtin_amdgcn_mfma_f32_32x32x16_bf16(vb0, pa[0][ks], oT[0][0], 0, 0, 0); oT[1][0] = __builtin_amdgcn_mfma_f32_32x32x16_bf16(vb1, pa[0][ks], oT[1][0], 0, 0, 0); }
            oT[0][1] = __builtin_amdgcn_mfma_f32_32x32x16_bf16(vb0, pa[1][ks], oT[0][1], 0, 0, 0); oT[1][1] = __builtin_amdgcn_mfma_f32_32x32x16_bf16(vb1, pa[1][ks], oT[1][1], 0, 0, 0);
        }
#pragma unroll
        for (int s2 = 0; s2 < 2; ++s2) {
            const bf16x8 q0f = *(const LAS bf16x8*)(wl + r32 * 64 + (16 * s2 + 8 * hi) * 2), q1f = *(const LAS bf16x8*)(wl + (32 + r32) * 64 + (16 * s2 + 8 * hi) * 2);
            const bf16x8 s0f = sfr[s2][0], s1f = sfr[s2][1];
            oT[0][0] = __builtin_amdgcn_mfma_f32_32x32x16_bf16(s0f, q0f, oT[0][0], 0, 0, 0); oT[1][0] = __builtin_amdgcn_mfma_f32_32x32x16_bf16(s1f, q0f, oT[1][0], 0, 0, 0);
            oT[0][1] = __builtin_amdgcn_mfma_f32_32x32x16_bf16(s0f, q1f, oT[0][1], 0, 0, 0); oT[1][1] = __builtin_amdgcn_mfma_f32_32x32x16_bf16(s1f, q1f, oT[1][1], 0, 0, 0);
        }
        unsigned yo_ = (unsigned)((tok + r32) * DM + YO + h * 64 + 4 * hi); asm volatile("" : "+v"(yo_));
        bf16_t* ypb = Y + yo_;
#pragma unroll
        for (int ib = 0; ib < 2; ++ib) {
            float ss = 0.f;
#pragma unroll
            for (int vb = 0; vb < 2; ++vb)
#pragma unroll
                for (int r = 0; r < 16; ++r) ss += oT[vb][ib][r] * oT[vb][ib][r];
            { auto sw = __builtin_amdgcn_permlane32_swap(__float_as_uint(ss), __float_as_uint(ss), false, false); ss = __uint_as_float(sw[0]) + __uint_as_float(sw[1]); }
            const float rstd = __builtin_amdgcn_rsqf(ss * (1.0f / 64.0f) + EPS);
#pragma unroll
            for (int vb = 0; vb < 2; ++vb)
#pragma unroll
                for (int g4 = 0; g4 < 4; ++g4) {
                    const u32x2 gw = gt[ib][vb * 4 + g4];
                    const float y0 = oT[vb][ib][4 * g4 + 0] * rstd * silu_f(bflo(gw[0])), y1 = oT[vb][ib][4 * g4 + 1] * rstd * silu_f(bfhi(gw[0]));
                    const float y2 = oT[vb][ib][4 * g4 + 2] * rstd * silu_f(bflo(gw[1])), y3 = oT[vb][ib][4 * g4 + 3] * rstd * silu_f(bfhi(gw[1]));
                    *(u32x2*)(ypb + (size_t)(32 * ib) * DM + 32 * vb + 8 * g4) = (u32x2){cvtpk(y0, y1), cvtpk(y2, y3)};
                }
        }
    }
    __syncthreads();
}

constexpr int LDS_RING = 0, LDS_X = 131072, LDS_RS = LDS_X + 12288, LDS_MISC = LDS_RS + 12288, LDS_BYTES = LDS_MISC + 256;
static_assert(8 * LW <= LDS_MISC && AT_LDS <= LDS_MISC && LDS_RS + 12288 <= LDS_MISC, "phase scratch must not reach the barrier words");
static_assert(CV_LDS >= AT_LDS && CV_LDS + 32768 <= LDS_MISC, "weight tile buffers sit above the attention image");
constexpr int NPH = 2 + 6 * DEPTH;

__global__ void __launch_bounds__(512, 2) mk_fwd(Params p) {
    extern __shared__ __attribute__((aligned(16))) unsigned char lds[];
    LAS unsigned char* ldsl = (LAS unsigned char*)lds;
    const int tid = threadIdx.x, G = gridDim.x, wg = blockIdx.x;
    volatile LAS unsigned* misc = (volatile LAS unsigned*)(ldsl + LDS_MISC);
    if (tid < 4) misc[tid] = 0u;
    __syncthreads();
    unsigned* barw = (unsigned*)(p.ws + WS_BAR);
    XcdBarrier bar; bar.bar = barw; bar.x = 0; bar.st = misc;
    if (ONE_LAUNCH) bar = xcd_barrier_post(barw, misc);
#define WSP() size_t wso_ = 0; asm volatile("" : "+s"(wso_)); unsigned char* ws = p.ws + wso_; \
    bf16_t* XB = (bf16_t*)(ws + WS_XB); bf16_t* YC = (bf16_t*)(ws + WS_YCAT); bf16_t* KRb = (bf16_t*)(ws + WS_KR); bf16_t* Zb = (bf16_t*)(ws + WS_Z); \
    bf16_t* Qb = (bf16_t*)(ws + WS_Q); bf16_t* KVb = (bf16_t*)(ws + WS_KV); bf16_t* Gb = (bf16_t*)(ws + WS_G); \
    float* ssqx = (float*)(ws + WS_SSQX); float* ssqq = (float*)(ws + WS_SSQQ); float* ssqkv = (float*)(ws + WS_SSQKV); \
    const float* rcm = (const float*)(ws + WS_ROPEM); const float* rsm = rcm + SEQ * 32; \
    float* halo = (float*)(ws + WS_HALO); float* heada = (float*)(ws + WS_HEADA); float* headb = (float*)(ws + WS_HEADB); \
    const unsigned char* wl_ = ws + WS_W + (size_t)l * W_LAYER; \
    (void)XB; (void)YC; (void)KRb; (void)Zb; (void)Qb; (void)KVb; (void)Gb; (void)ssqx; (void)ssqq; (void)ssqkv; (void)rcm; (void)rsm; (void)halo; (void)heada; (void)headb; (void)wl_
#define RUN(k) (p.ph_lo <= (k) && (k) < p.ph_hi)
#define SEAM(k) do { if (RUN(k) && RUN((k) + 1)) xcd_barrier(bar); } while (0)
    REP(0) if (EN(0) && RUN(0)) prologue(p, (lptr)lds);
    SEAM(0);
    for (int l = 0; l < DEPTH; ++l) {
        const int pb = 1 + 6 * l;
        if (EN(1) && RUN(pb + 0)) { WSP();
            pg8::Gemm g{XB, (const bf16_t*)(wl_ + W_IN), DM, DM, DM}; pg8::StaticOrder S; S.init(MTOK / 256, NZ / 256 - 1, G, wg);
            REP(1) { pg8::EpiZ E{Zb, KRb, ssqx, ssqq, ssqkv, rcm, rsm, ldsl + LDS_X, (REP_NOEPI && ((REP_MASK >> 1) & 1) && rep_ == 0) ? 1 : 0};
            pg8::gemm_phase(ldsl + LDS_RING, g, S, E, (LAS float*)(ldsl + LDS_RS)); }
        }
        SEAM(pb + 0);
        if (RUN(pb + 1)) { WSP();
            REP(2) if (EN(2) && EN(11)) { pg8::Gemm g{Zb + ZC_CQ, (const bf16_t*)(wl_ + W_UQ), NZ, 384, 384}; pg8::StaticOrder S; S.init(MTOK / 256, NQ / 256, G, wg);
              pg8::EpiQ E{Qb, ssqq, rcm, rsm}; pg8::gemm_phase(ldsl + LDS_RING, g, S, E, (LAS float*)(ldsl + LDS_RS)); }
            REP(2) if (EN(2) && EN(12)) { pg8::Gemm g{XB, (const bf16_t*)(wl_ + W_IN), DM, DM, DM}; pg8::StaticOrder S; S.init(MTOK / 256, 1, G, G == 256 ? (wg >= 128 ? wg - 128 : 128) : wg); S.pn0 = NZ / 256 - 1;
              pg8::EpiZ E{Zb, KRb, ssqx, ssqq, ssqkv, rcm, rsm, ldsl + LDS_X, 0}; pg8::gemm_phase(ldsl + LDS_RING, g, S, E, (LAS float*)(ldsl + LDS_RS)); }
            REP(2) if (EN(2) && EN(12)) { pg8::Gemm g{Zb + ZC_CKV, (const bf16_t*)(wl_ + W_UKV), NZ, 256, 256}; pg8::StaticOrder S;
              if (G == 256) { S.init(MTOK / 256, NKV / 256, 128, wg < 128 ? wg : wg + 256); S.imax = wg < 128 ? 3 : 1; } else S.init(MTOK / 256, NKV / 256, G, (wg + 128) % G);
              pg8::EpiKV E{KVb, ssqkv}; pg8::gemm_phase(ldsl + LDS_RING, g, S, E, (LAS float*)(ldsl + LDS_RS)); }
            REP(3) if (EN(3)) for (int u = wg; u < 256; u += G) { if (u < 128) lin_unit<true>((lptr)lds, p, l, u >> 3, u & 7, 1, u); else lin_unit<false>((lptr)lds, p, l, (u - 128) >> 3, u & 7, 1, u); }
        }
        SEAM(pb + 1);
        if (RUN(pb + 2)) { WSP();
            const float* gain = p.in[7] + l * 512;
            int cv_it = (l + 1) * W_TILES_PER_LAYER + wg; const int cv_end = (l + 1 < DEPTH) ? (l + 2) * W_TILES_PER_LAYER : 0;
            REP(4) if (EN(4)) for (int u = wg; u < 256; u += G) {
                const int xcd = u & 7, idx = u >> 3, bh = xcd * 2 + (idx >> 4), pr = idx & 15;
#pragma nounroll
                for (int k2 = 0; k2 < 2; ++k2) attn_unit16((lptr)lds, Qb, KVb, KRb, YC, bh >> 2, bh & 3, k2 ? pr : 31 - pr, k2 != 0, p, cv_it, cv_end);
            }
            if (REP_MASK == 0) wconvert(p, (lptr)lds, cv_it, cv_end);
            REP(5) if (EN(5)) for (int u = wg; u < 256; u += G) { if (u < 128) lin_unit<true>((lptr)lds, p, l, u >> 3, u & 7, 2, u); else lin_unit<false>((lptr)lds, p, l, (u - 128) >> 3, u & 7, 2, u); }
        }
        SEAM(pb + 2);
        if (EN(6) && RUN(pb + 3)) { WSP();
            pg8::Gemm g{YC, (const bf16_t*)(wl_ + W_OUT), DM, DM, DM}; pg8::StaticOrder S; S.init(MTOK / 256, DM / 256, G, wg);
            REP(6) { pg8::EpiRes E{XB, ssqx, ldsl + LDS_X, (((REP_MASK >> 6) & 1) && rep_ == 0) ? (REP_NOEPI ? -1.f : 0.f) : 1.f};
            pg8::gemm_phase(ldsl + LDS_RING, g, S, E, (LAS float*)(ldsl + LDS_RS)); }
        }
        SEAM(pb + 3);
        if (EN(7) && RUN(pb + 4)) { WSP();
            pg8::Gemm g{XB, (const bf16_t*)(wl_ + W_UP), DM, DM, DM}; pg8::StaticOrder S; S.init(MTOK / 256, NUP / 256, G, wg);
            REP(7) { pg8::EpiUp E{Gb, ssqx, p.in[15] + (size_t)l * 3 * DFF, p.in[16] + (size_t)l * DFF, halo, heada, headb, ldsl + LDS_X, (REP_NOEPI && ((REP_MASK >> 7) & 1) && rep_ == 0) ? 1 : 0};
            pg8::gemm_phase(ldsl + LDS_RING, g, S, E, (LAS float*)(ldsl + LDS_RS)); }
        }
        SEAM(pb + 4);
        if (EN(9) && RUN(pb + 5)) { WSP();
            pg8::Gemm g{Gb, (const bf16_t*)(wl_ + W_DN), DFF, DFF, DFF}; pg8::StaticOrder S; S.init(MTOK / 256, DM / 256, G, wg);
            { const float* cw = p.in[15] + (size_t)l * 3 * DFF; const float* cb = p.in[16] + (size_t)l * DFF; const int tl = ltid();
              pg8::Unit uu; int prev = -1;
              for (int ui = 0; S.next(ui, uu); ++ui) { const int pm = uu.pm; if (pm == prev) continue; prev = pm;
                const bool fob = (pm % 32) == 0;
                for (int i = tl; i < 2 * (DFF / 4); i += 512) {
                    const int c = (i % (DFF / 4)) * 4, r = i / (DFF / 4);
                    const f32x4 zero = (f32x4){0.f, 0.f, 0.f, 0.f};
                    const f32x4 ac = *(const f32x4*)(heada + (size_t)(pm * 2 + r) * DFF + c), bq = *(const f32x4*)(headb + (size_t)(pm * 2 + r) * DFF + c);
                    const f32x4 h1 = fob ? zero : *(const f32x4*)(halo + (size_t)((pm - 1) * 2 + 1) * DFF + c), h0 = fob ? zero : *(const f32x4*)(halo + (size_t)((pm - 1) * 2 + 0) * DFF + c);
                    const f32x4 am1 = (r == 1) ? *(const f32x4*)(heada + (size_t)(pm * 2) * DFF + c) : h1, am2 = (r == 1) ? h1 : h0;
                    const f32x4 w0 = *(const f32x4*)(cw + c), w1 = *(const f32x4*)(cw + DFF + c), w2 = *(const f32x4*)(cw + 2 * DFF + c), bbv = *(const f32x4*)(cb + c);
                    float gv[4];
#pragma unroll
                    for (int j = 0; j < 4; ++j) gv[j] = silu_f(bbv[j] + w0[j] * am2[j] + w1[j] * am1[j] + w2[j] * ac[j]) * bq[j];
                    *(u32x2*)(Gb + (size_t)(pm * 256 + r) * DFF + c) = (u32x2){cvtpk(gv[0], gv[1]), cvtpk(gv[2], gv[3])};
                } }
              asm volatile("s_waitcnt vmcnt(0)" ::: "memory"); __syncthreads(); }
            REP(9) { pg8::EpiRes E{XB, ssqx, ldsl + LDS_X, (((REP_MASK >> 9) & 1) && rep_ == 0) ? (REP_NOEPI ? -1.f : 0.f) : 1.f};
            pg8::gemm_phase(ldsl + LDS_RING, g, S, E, (LAS float*)(ldsl + LDS_RS)); }
        }
        SEAM(pb + 5);
    }
    if (EN(10) && RUN(NPH - 1)) { const int l = 0; WSP();
        const float* fg = p.in[18]; const int tl = ltid(), lane = tl & 63, wv = tl >> 6;
        for (int row = wg * 8 + wv; row < MTOK; row += G * 8) {
            const f32x4 q = *(const f32x4*)(ssqx + (size_t)row * 4);
            const float rstd = __builtin_amdgcn_rsqf(((q[0] + q[1]) + (q[2] + q[3])) * (1.0f / 1024.0f) + EPS);
#pragma unroll
            for (int i = 0; i < 2; ++i) { const size_t o = (size_t)row * DM + i * 512 + lane * 8;
                const u32x4 w = *(const u32x4*)(XB + o);
                const f32x4 g0 = *(const f32x4*)(fg + i * 512 + lane * 8), g1 = *(const f32x4*)(fg + i * 512 + lane * 8 + 4);
                *(f32x4*)(p.out + o) = (f32x4){bflo(w[0]), bfhi(w[0]), bflo(w[1]), bfhi(w[1])} * rstd * g0;
                *(f32x4*)(p.out + o + 4) = (f32x4){bflo(w[2]), bfhi(w[2]), bflo(w[3]), bfhi(w[3])} * rstd * g1; }
        }
    }
#undef RUN
#undef SEAM
}

extern "C" void kernel_launch(void* const* d_in, const int* in_sizes, int n_in, void* d_out, int out_size, void* d_ws, size_t ws_size, hipStream_t stream) {
    static int grid = 0;
    if (grid == 0) {
        if (n_in != 19 || in_sizes[0] != MTOK * DM || out_size != MTOK * DM || ws_size < WS_END) {
            fprintf(stderr, "kernel_launch: unexpected problem (n_in %d, in0 %d, out %d, ws %zu < %zu); nothing launched\n", n_in, n_in > 0 ? in_sizes[0] : -1, out_size, ws_size, (size_t)WS_END); grid = -1; return; }
        int dev = 0, cus = 0, per_cu = 0;
        if (hipGetDevice(&dev) != hipSuccess || hipDeviceGetAttribute(&cus, hipDeviceAttributeMultiprocessorCount, dev) != hipSuccess) { grid = -1; return; }
        if (hipFuncSetAttribute((const void*)mk_fwd, hipFuncAttributeMaxDynamicSharedMemorySize, LDS_BYTES) != hipSuccess) { fprintf(stderr, "kernel_launch: hipFuncSetAttribute failed\n"); grid = -1; return; }
        if (hipOccupancyMaxActiveBlocksPerMultiprocessor(&per_cu, (const void*)mk_fwd, 512, LDS_BYTES) != hipSuccess || per_cu < 1) { fprintf(stderr, "kernel_launch: occupancy query says %d\n", per_cu); (void)hipGetLastError(); }
        grid = cus;
    }
    if (grid < 0) return;
    (void)hipMemsetAsync((char*)d_ws + WS_BAR, 0, 16384, stream);
    Params p{};
    for (int i = 0; i < 19; ++i) p.in[i] = (const float*)d_in[i];
    p.out = (float*)d_out; p.ws = (unsigned char*)d_ws;
#if ONE_LAUNCH
    p.ph_lo = 0; p.ph_hi = NPH;
    hipLaunchKernelGGL(mk_fwd, dim3(grid), dim3(512), LDS_BYTES, stream, p);
#else
    for (int k = 0; k < NPH; ++k) { p.ph_lo = k; p.ph_hi = k + 1; hipLaunchKernelGGL(mk_fwd, dim3(grid), dim3(512), LDS_BYTES, stream, p); }
#endif
}
```
